# Optimizing an MI355X kernel written in HIP

```python
import jax, jax.numpy as jnp
from jax import lax
import numpy as np

D_MODEL = 1024
BATCH = 8
SEQ = 2048
DEPTH = 2
DEC_BATCH = 128
DEC_SEQ = 1
PAST_LEN = 16384
PAGE_SIZE = 128

GLA_HEADS = 4
GLA_DK = D_MODEL // 8
GLA_DV = D_MODEL // 4
GLA_RANK = 16
GLA_TAU = 16.0
GLA_CHUNK = 64
QK_TOT = GLA_HEADS * GLA_DK
V_TOT = GLA_HEADS * GLA_DV
CONV_WIDTH = D_MODEL // 2
CONV_K = 3
ALPHA = (2 * DEPTH) ** 0.25
BETA = (8 * DEPTH) ** -0.25
EPS = 1e-5
SPLITS = (QK_TOT, QK_TOT, V_TOT, V_TOT, GLA_RANK, CONV_WIDTH, CONV_WIDTH, CONV_WIDTH, CONV_WIDTH, D_MODEL, D_MODEL)
VALUE_SLOTS = (2, 7)
N_IN = sum(SPLITS)

kernel_name = "gla_shortconv_gated_merge_deepnorm_step"


def _split_in(z):
    out = []
    off = 0
    for n in SPLITS:
        out.append(z[..., off:off + n])
        off += n
    return out


def _layernorm(x, g, b):
    xf = x.astype(jnp.float32)
    mu = jnp.mean(xf, axis=-1, keepdims=True)
    var = jnp.mean(jnp.square(xf - mu), axis=-1, keepdims=True)
    return ((xf - mu) * lax.rsqrt(var + EPS) * g + b).astype(x.dtype)


def _head_rmsnorm(o, g):
    return o * lax.rsqrt(jnp.mean(jnp.square(o), axis=-1, keepdims=True) + EPS) * g


def _gla_chunked(q, k, v, log_a, s0):
    bsz, L = q.shape[0], q.shape[1]
    C = min(GLA_CHUNK, L)
    n = -(-L // C)
    pad = n * C - L

    def prep(t):
        t = jnp.pad(t.astype(jnp.float32), ((0, 0), (0, pad), (0, 0), (0, 0)))
        return t.reshape(bsz, n, C, t.shape[2], t.shape[3]).transpose(0, 3, 1, 2, 4)

    q, k, v, g = prep(q), prep(k), prep(v), prep(log_a)
    q = q * (GLA_DK ** -0.5)
    b = jnp.cumsum(g, axis=3)
    b_last = b[:, :, :, -1:, :]
    q_in = q * jnp.exp(b)
    k_in = k * jnp.exp(-b)
    k_st = k * jnp.exp(b_last - b)
    mask = jnp.tril(jnp.ones((C, C), dtype=bool))
    att = jnp.where(mask, jnp.einsum('bhnik,bhnjk->bhnij', q_in, k_in), 0.0)
    o_intra = jnp.einsum('bhnij,bhnjv->bhniv', att, v)
    d_state = jnp.einsum('bhnjk,bhnjv->bhnkv', k_st, v)
    decay = jnp.exp(b_last[:, :, :, 0, :])

    def step(S, inp):
        d, ds = inp
        return d[..., None] * S + ds, S

    s_fin, s_prev = lax.scan(step, s0.astype(jnp.float32),
                             (jnp.moveaxis(decay, 2, 0), jnp.moveaxis(d_state, 2, 0)))
    s_prev = jnp.moveaxis(s_prev, 0, 2)
    o = o_intra + jnp.einsum('bhnik,bhnkv->bhniv', q_in, s_prev)
    o = o.transpose(0, 2, 3, 1, 4).reshape(bsz, n * C, GLA_HEADS, GLA_DV)[:, :L]
    return o, s_fin


def _short_conv(z, buf, w):
    L = z.shape[1]
    zz = jnp.concatenate([buf.astype(z.dtype), z], axis=1)
    y = zz[:, 0:L] * w[0]
    for i in range(1, CONV_K):
        y = y + zz[:, i:i + L] * w[i]
    return y, zz[:, -(CONV_K - 1):]


def _layer(x, c, s_gla, s_conv, w_ada, b_ada, w_in, w_a2, b_a, gla_norm_g, conv_w, w_pa, w_pb, w_o, ln_g, ln_b):
    bsz, L, _ = x.shape
    shift, scale, gate = jnp.split(c @ w_ada + b_ada, 3, axis=-1)
    u = x * (1.0 + scale[:, None, :]) + shift[:, None, :]
    (q, k, v, g_gla, a_lr, cb, cc, ch, g_conv, m_gla, m_conv) = _split_in(u @ w_in)
    log_a = jax.nn.log_sigmoid((a_lr @ w_a2 + b_a).astype(jnp.float32)) / GLA_TAU
    hk = lambda t: t.reshape(bsz, L, GLA_HEADS, -1)
    o, s_gla_new = _gla_chunked(hk(q), hk(k), hk(v), hk(log_a), s_gla)
    o = _head_rmsnorm(o, gla_norm_g).reshape(bsz, L, V_TOT).astype(x.dtype) * jax.nn.silu(g_gla)
    yc, s_conv_new = _short_conv(cc * ch, s_conv, conv_w)
    yc = cb * yc * jax.nn.silu(g_conv)
    merged = jax.nn.sigmoid(m_gla) * (o @ w_pa) + jax.nn.sigmoid(m_conv) * (yc @ w_pb)
    out = merged @ w_o
    y = _layernorm(ALPHA * x + gate[:, None, :] * out, ln_g, ln_b)
    return y, s_gla_new, s_conv_new


def setup_inputs(seed: int = 0) -> dict:
    key = jax.random.key(seed)
    ks = jax.random.split(key, 20)
    f32 = jnp.float32
    nrm = lambda kk, shape, s: jax.random.normal(kk, shape, f32) * s
    col_scale = jnp.concatenate([jnp.full((n,), BETA if i in VALUE_SLOTS else 1.0, f32)
                                 for i, n in enumerate(SPLITS)])
    return {
        "x_prompt": nrm(ks[0], (BATCH, SEQ, D_MODEL), 1.0),
        "x_sample": nrm(ks[1], (DEC_BATCH, DEC_SEQ, D_MODEL), 1.0),
        "c_prompt": nrm(ks[2], (BATCH, D_MODEL), 1.0),
        "c_sample": nrm(ks[3], (DEC_BATCH, D_MODEL), 1.0),
        "state_gla": nrm(ks[4], (DEPTH, DEC_BATCH, GLA_HEADS, GLA_DK, GLA_DV), 0.5),
        "state_conv": nrm(ks[5], (DEPTH, DEC_BATCH, CONV_K - 1, CONV_WIDTH), 1.0),
        "w_ada": nrm(ks[6], (DEPTH, D_MODEL, 3 * D_MODEL), 0.5 * D_MODEL ** -0.5),
        "b_ada": nrm(ks[7], (DEPTH, 3 * D_MODEL), 0.02),
        "w_in": nrm(ks[8], (DEPTH, D_MODEL, N_IN), D_MODEL ** -0.5) * col_scale,
        "w_a2": nrm(ks[9], (DEPTH, GLA_RANK, QK_TOT), GLA_RANK ** -0.5),
        "b_a": nrm(ks[10], (DEPTH, QK_TOT), 0.1),
        "gla_norm_g": 1.0 + nrm(ks[11], (DEPTH, GLA_DV), 0.02),
        "conv_w": nrm(ks[12], (DEPTH, CONV_K, CONV_WIDTH), CONV_K ** -0.5),
        "w_pa": nrm(ks[13], (DEPTH, V_TOT, D_MODEL), BETA * V_TOT ** -0.5),
        "w_pb": nrm(ks[14], (DEPTH, CONV_WIDTH, D_MODEL), BETA * CONV_WIDTH ** -0.5),
        "w_o": nrm(ks[15], (DEPTH, D_MODEL, D_MODEL), BETA * D_MODEL ** -0.5),
        "ln_g": 1.0 + nrm(ks[16], (DEPTH, D_MODEL), 0.02),
        "ln_b": nrm(ks[17], (DEPTH, D_MODEL), 0.02),
    }


def reference(x_prompt, x_sample, c_prompt, c_sample, state_gla, state_conv, w_ada, b_ada, w_in, w_a2, b_a,
              gla_norm_g, conv_w, w_pa, w_pb, w_o, ln_g, ln_b):
    hp, hs = x_prompt, x_sample
    bp = x_prompt.shape[0]
    gla_p, conv_p, gla_s, conv_s = [], [], [], []
    for l in range(DEPTH):
        wl = (w_ada[l], b_ada[l], w_in[l], w_a2[l], b_a[l], gla_norm_g[l], conv_w[l],
              w_pa[l], w_pb[l], w_o[l], ln_g[l], ln_b[l])
        s0 = jnp.zeros((bp, GLA_HEADS, GLA_DK, GLA_DV), jnp.float32)
        buf0 = jnp.zeros((bp, CONV_K - 1, CONV_WIDTH), x_prompt.dtype)
        hp, sg, sc = _layer(hp, c_prompt, s0, buf0, *wl)
        gla_p.append(sg)
        conv_p.append(sc)
        hs, sg2, sc2 = _layer(hs, c_sample, state_gla[l], state_conv[l], *wl)
        gla_s.append(sg2)
        conv_s.append(sc2)
    return (hp, hs, jnp.stack(gla_p), jnp.stack(conv_p), jnp.stack(gla_s), jnp.stack(conv_s))
```

```cpp
#include <hip/hip_runtime.h>
#include <hip/hip_cooperative_groups.h>
#include <cstdio>
#include <cstdint>
namespace cg = cooperative_groups;
#ifndef USE_XCD_BAR
#define USE_XCD_BAR 1
#endif
#ifndef N_LAUNCH_PER_PHASE
#define N_LAUNCH_PER_PHASE 0
#endif
#define LAS __attribute__((address_space(3)))
__device__ __forceinline__ int opaque_zero() { int z; asm volatile("s_mov_b32 %0, 0" : "=s"(z)); return z; }
namespace pg8 {
#define PG8_LAS __attribute__((address_space(3)))
typedef unsigned short bf16_t;
typedef short bf16x8 __attribute__((ext_vector_type(8)));
typedef float f32x4 __attribute__((ext_vector_type(4)));
typedef unsigned u32x4 __attribute__((ext_vector_type(4)));
constexpr int BM = 256, BK = 64, HALF = 128, HTB = HALF * BK * 2  , STAGE_BYTES = 8 * HTB, NXCD = 8, WGM = 8;

__host__ __device__ __forceinline__ int lds_byte(int r, int c) { const int st = (r >> 4) * 2 + (c >> 5), rr = r & 15, cc = c & 31, ob = rr * 64 + cc * 2; return st * 1024 + (ob ^ (((ob >> 9) & 1) << 5)); }
__host__ __device__ __forceinline__ void stage_rc(int b, int& R, int& C) { const int st = b / 1024, sb = b % 1024, swz = sb ^ (((sb >> 9) & 1) << 5); R = (st >> 1) * 16 + swz / 64; C = (st & 1) * 32 + (swz % 64) / 2; }
__host__ __device__ __forceinline__ int perm32(int rho) { const int n = rho >> 4, i = rho & 15; return 8 * (i >> 2) + 4 * n + (i & 3); }
struct Unit { int pm, pn; };
struct Gemm { const bf16_t* A; const bf16_t* Bt; int M, N, K; };

struct StaticOrder {
    int nM, nN, nwg, G, c;
    __host__ __device__ void init(int M, int N, int G_, int c_) { nM = M / BM; nN = N / BM; nwg = nM * nN; G = G_; c = c_; }
    __host__ __device__ bool next(int i, Unit& u) const {
        const long L = (long)i * G + c; if (L >= nwg) return false;
        int wgid = (int)L; { const int q = nwg / NXCD, r = nwg % NXCD, xcd = wgid % NXCD, off = wgid / NXCD; wgid = (xcd < r ? xcd * (q + 1) : r * (q + 1) + (xcd - r) * q) + off; }
        const int nig = WGM * nN, gid = wgid / nig, fm = gid * WGM, gsz = (nM - fm) < WGM ? (nM - fm) : WGM;
        u.pm = fm + ((wgid % nig) % gsz); u.pn = (wgid % nig) / gsz; return true;
    }
    __device__ __forceinline__ void a_ready(const Unit&) const {}
    __device__ __forceinline__ void done(const Unit&) const {}
};
typedef __bf16 bf16x2n __attribute__((ext_vector_type(2)));
typedef float f32x2n __attribute__((ext_vector_type(2)));
__device__ __forceinline__ unsigned cvt_pk_bf16(float lo, float hi) { f32x2n v = {lo, hi}; bf16x2n b = __builtin_convertvector(v, bf16x2n); return __builtin_bit_cast(unsigned, b); }
template <class Epi, class Sched, bool STAMP = false>
__device__ __forceinline__ void gemm_phase(PG8_LAS unsigned char* lds, const Gemm g, const Sched& S, const Epi& E, unsigned long long* stamps) {
    const int tid = threadIdx.x + opaque_zero(), wid = __builtin_amdgcn_readfirstlane(tid >> 6), lane = tid & 63, wr = wid >> 2, wc = wid & 3, fr = lane & 15, fq = lane >> 4;
    const int K = g.K, nt = K / BK;
    int ts_lo = 0, ts_hi = 0, nts = 0; const unsigned long long rt_entry = STAMP ? (unsigned long long)wall_clock64() : 0ull;
#define PG8_STAMP() do { if (STAMP && wid == 0 && nts < 64) { const unsigned long long _c = (unsigned long long)clock64(); \
        ts_lo = (lane == nts) ? (int)(unsigned)_c : ts_lo; ts_hi = (lane == nts) ? (int)(unsigned)(_c >> 32) : ts_hi; ++nts; } } while (0)
    PG8_STAMP();
    unsigned voffA[2], voffB[2];
#pragma unroll
    for (int i = 0; i < 2; ++i) { int R, C; stage_rc(tid * 16 + i * 8192, R, C); const int Rb = Epi::PERM ? ((R & ~31) + perm32(R & 31)) : R;
        voffA[i] = (unsigned)(R * K + C) * 2u; voffB[i] = (unsigned)(Rb * K + C) * 2u; }
    const size_t kstep = (size_t)(BK * 2);
    const size_t hstep = (size_t)HALF * K * 2;
    const size_t tstep = 2 * hstep;
    const unsigned ldsw = (unsigned)wid * 1024u;
    const int aoff = lds_byte(wr * 64 + fr, fq * 8), boff = lds_byte(wc * 32 + fr, fq * 8);
#define PG8_SA(b, h) (((b) * 2 + (h)) * HTB)
#define PG8_SB(b, h) ((4 + (b) * 2 + (h)) * HTB)
#define PG8_STAGE(bufoff, gbase, voff) do { _Pragma("unroll") for (int _i = 0; _i < 2; ++_i) \
        __builtin_amdgcn_global_load_lds((const unsigned*)((const char*)(gbase) + (voff)[_i]), (PG8_LAS unsigned*)(lds + (bufoff) + ldsw + _i * 8192), 16, 0, 0); } while (0)
#define PG8_LDA(dst, b, h) do { _Pragma("unroll") for (int m = 0; m < 4; ++m) _Pragma("unroll") for (int k = 0; k < 2; ++k) dst[m][k] = *(const PG8_LAS bf16x8*)(lds + PG8_SA(b, h) + aoff + m * 2048 + k * 1024); } while (0)
#define PG8_LDB(dst, b, h) do { _Pragma("unroll") for (int n = 0; n < 2; ++n) _Pragma("unroll") for (int k = 0; k < 2; ++k) dst[n][k] = *(const PG8_LAS bf16x8*)(lds + PG8_SB(b, h) + boff + n * 2048 + k * 1024); } while (0)
#define PG8_MMA(ai, bj, At, Bt) do { __builtin_amdgcn_s_setprio(1); _Pragma("unroll") for (int m = 0; m < 4; ++m) _Pragma("unroll") for (int n = 0; n < 2; ++n) _Pragma("unroll") for (int k = 0; k < 2; ++k) \
        acc[ai][bj][m][n] = __builtin_amdgcn_mfma_f32_16x16x32_bf16(Bt[n][k], At[m][k], acc[ai][bj][m][n], 0, 0, 0); __builtin_amdgcn_s_setprio(0); } while (0)
#define PG8_WAIT_V(n) asm volatile("s_waitcnt vmcnt(" #n ")" ::: "memory")
#define PG8_WAIT_L(n) asm volatile("s_waitcnt lgkmcnt(" #n ")" ::: "memory")
#define PG8_BAR __builtin_amdgcn_s_barrier()
#define PG8_SCHED __builtin_amdgcn_sched_barrier(0)
    Unit cur, nxt; int ui = 0;
    if (!S.next(0, cur)) return;
    f32x4 acc[2][2][4][2];
#pragma unroll
    for (int a = 0; a < 2; ++a)
#pragma unroll
        for (int b = 0; b < 2; ++b)
#pragma unroll
            for (int m = 0; m < 4; ++m)
#pragma unroll
                for (int n = 0; n < 2; ++n) acc[a][b][m][n] = (f32x4){0.f, 0.f, 0.f, 0.f};
    bf16x8 At[4][2], B0[2][2], B1[2][2];
    const char* cA = (const char*)g.A + (size_t)cur.pm * tstep; const char* cB = (const char*)g.Bt + (size_t)cur.pn * tstep;
    S.a_ready(cur);
    PG8_STAGE(PG8_SB(0, 0), cB, voffB); PG8_STAGE(PG8_SA(0, 0), cA, voffA); PG8_STAGE(PG8_SB(0, 1), cB + hstep, voffB); PG8_STAGE(PG8_SA(0, 1), cA + hstep, voffA);
    if (wr == 1) PG8_BAR;
    PG8_WAIT_V(4); PG8_BAR;
    PG8_STAGE(PG8_SB(1, 0), cB + kstep, voffB); PG8_STAGE(PG8_SA(1, 0), cA + kstep, voffA); PG8_STAGE(PG8_SB(1, 1), cB + hstep + kstep, voffB);
    PG8_WAIT_V(6); PG8_BAR;
    PG8_STAMP();
    for (;;) {
        const bool has_next = S.next(ui + 1, nxt);
        const char* nA = has_next ? (const char*)g.A + (size_t)nxt.pm * tstep : cA; const char* nB = has_next ? (const char*)g.Bt + (size_t)nxt.pn * tstep : cB;
        for (int t = 0; t < nt; t += 2) {
            const bool last = (t == nt - 2);
            const char* a1 = cA + (size_t)(t + 1) * kstep;
            const char* a2 = last ? nA : cA + (size_t)(t + 2) * kstep; const char* b2 = last ? nB : cB + (size_t)(t + 2) * kstep;
            const char* a3 = a2 + kstep; const char* b3 = b2 + kstep;
            if (last && has_next) S.a_ready(nxt);
            PG8_LDB(B0, 0, 0); PG8_SCHED; PG8_LDA(At, 0, 0); PG8_STAGE(PG8_SA(1, 1), a1 + hstep, voffA);
            PG8_WAIT_L(8); PG8_BAR; PG8_WAIT_L(0); PG8_MMA(0, 0, At, B0); PG8_BAR; PG8_SCHED;
            PG8_LDB(B1, 0, 1); PG8_STAGE(PG8_SB(0, 0), b2, voffB);
            PG8_BAR; PG8_WAIT_L(0); PG8_MMA(0, 1, At, B1); PG8_BAR;
            PG8_LDA(At, 0, 1); PG8_STAGE(PG8_SA(0, 0), a2, voffA);
            PG8_BAR; PG8_WAIT_L(0); PG8_MMA(1, 0, At, B0); PG8_BAR; PG8_SCHED;
            PG8_STAGE(PG8_SB(0, 1), b2 + hstep, voffB);
            PG8_WAIT_V(6); PG8_BAR; PG8_MMA(1, 1, At, B1); PG8_BAR;
            PG8_LDB(B0, 1, 0); PG8_SCHED; PG8_LDA(At, 1, 0); PG8_STAGE(PG8_SA(0, 1), a2 + hstep, voffA);
            PG8_WAIT_L(8); PG8_BAR; PG8_WAIT_L(0); PG8_MMA(0, 0, At, B0); PG8_BAR; PG8_SCHED;
            PG8_LDB(B1, 1, 1); PG8_STAGE(PG8_SB(1, 0), b3, voffB);
            PG8_BAR; PG8_WAIT_L(0); PG8_MMA(0, 1, At, B1); PG8_BAR;
            PG8_LDA(At, 1, 1); PG8_STAGE(PG8_SA(1, 0), a3, voffA);
            PG8_BAR; PG8_WAIT_L(0); PG8_MMA(1, 0, At, B0); PG8_BAR; PG8_SCHED;
            PG8_STAGE(PG8_SB(1, 1), b3 + hstep, voffB);
            PG8_WAIT_V(6); PG8_BAR; PG8_MMA(1, 1, At, B1); PG8_BAR;
        }
        PG8_STAMP();
        if constexpr (!Epi::AFTER_DRAIN) { E(acc, cur, wr, wc, fr, fq); S.done(cur); }
        PG8_STAMP();
        if (!has_next) break;
#pragma unroll
        for (int a = 0; a < 2; ++a)
#pragma unroll
            for (int b = 0; b < 2; ++b)
#pragma unroll
                for (int m = 0; m < 4; ++m)
#pragma unroll
                    for (int n = 0; n < 2; ++n) acc[a][b][m][n] = (f32x4){0.f, 0.f, 0.f, 0.f};
        cur = nxt; cA = nA; cB = nB; ++ui;
    }
    PG8_WAIT_V(0);
    if (wr == 0) PG8_BAR;
    PG8_BAR;
    if constexpr (Epi::AFTER_DRAIN) { E.fused(acc, cur, wr, wc, fr, fq, lds, wid, lane); S.done(cur); }
    PG8_STAMP();
    if (STAMP && wid == 0) { stamps[lane] = lane < nts ? (((unsigned long long)(unsigned)ts_hi << 32) | (unsigned)ts_lo) : 0ull;
        if (lane == 62) stamps[62] = rt_entry; if (lane == 63) stamps[63] = (unsigned long long)wall_clock64(); }
#undef PG8_STAMP
#undef PG8_SA
#undef PG8_SB
#undef PG8_STAGE
#undef PG8_LDA
#undef PG8_LDB
#undef PG8_MMA
#undef PG8_WAIT_V
#undef PG8_WAIT_L
#undef PG8_BAR
#undef PG8_SCHED
}
}
#define XB_TMO      128
#define XB_XCNT(j)  (256  + 64 * (j))
#define XB_XSUB(j)  (1280 + 64 * (j))
#define XB_XGEN(j)  (2304 + 64 * (j))
#define XB_TOP      3328
#define XB_TOPGEN   3392
#define XCD_BAR_WORDS 3456
#define XB_SPIN_CAP (1u << 18)

__device__ __forceinline__ unsigned xb_ld(unsigned* p)              { return __hip_atomic_load(p, __ATOMIC_RELAXED, __HIP_MEMORY_SCOPE_AGENT); }
__device__ __forceinline__ unsigned xb_add(unsigned* p, unsigned v) { return __hip_atomic_fetch_add(p, v, __ATOMIC_RELAXED, __HIP_MEMORY_SCOPE_AGENT); }
__device__ __forceinline__ unsigned xb_xcc_id() { return (unsigned)__builtin_amdgcn_s_getreg((3 << 11) | 20) & 0xFu; }
#define XB_SPIN(cond, bar) do { unsigned _sp = 0; while (cond) { __builtin_amdgcn_s_sleep(1); \
    if ((++_sp & 255u) == 0u) { if (xb_ld(&(bar)[XB_TMO])) break; if (_sp > XB_SPIN_CAP) { atomicAdd(&(bar)[XB_TMO], 1u); break; } } } } while (0)

struct XcdBarrier {
    unsigned* bar; unsigned x;
    volatile LAS unsigned* st;
};

__device__ __forceinline__ XcdBarrier xcd_barrier_post(unsigned* bar, volatile LAS unsigned* st) {
    XcdBarrier b; b.bar = bar; b.x = xb_xcc_id(); b.st = st;
    if (threadIdx.x == 0) (void)xb_add(&bar[XB_XCNT(b.x)], 1u);
    return b;
}
__device__ __forceinline__ void xcd_barrier_complete(unsigned* bar, unsigned x, unsigned& nloc, unsigned& nx) {
    const unsigned G = gridDim.x * gridDim.y * gridDim.z;
    unsigned sum, cnt, mine, sp = 0u;
    for (;;) {
        sum = 0u; cnt = 0u; mine = 0u;
#pragma unroll
        for (unsigned j = 0; j < 16; ++j) { const unsigned c = xb_ld(&bar[XB_XCNT(j)]); sum += c; cnt += (c > 0u) ? 1u : 0u; mine = (j == x) ? c : mine; }
        if (sum == G) break;
        __builtin_amdgcn_s_sleep(1);
        if ((++sp & 255u) == 0u) { if (xb_ld(&bar[XB_TMO])) break; if (sp > XB_SPIN_CAP) { atomicAdd(&bar[XB_TMO], 1u); break; } }
    }
    nloc = mine > 0u ? mine : 1u; nx = cnt > 0u ? cnt : 1u;
}

__device__ __forceinline__ void xcd_barrier(const XcdBarrier& b) {
    asm volatile("s_waitcnt vmcnt(0)" ::: "memory");
    __syncthreads();
    if (threadIdx.x == 0) {
        unsigned* bar = b.bar;
        __builtin_amdgcn_s_waitcnt(0);
        unsigned nloc = b.st[0], nx = b.st[1];
        if (nloc == 0u) { xcd_barrier_complete(bar, b.x, nloc, nx); b.st[0] = nloc; b.st[1] = nx; }
        const unsigned old = xb_add(&bar[XB_XSUB(b.x)], 1u);
        const unsigned gen = old / nloc;
        if (old + 1u == (gen + 1u) * nloc) {
            __builtin_amdgcn_fence(__ATOMIC_RELEASE, "agent");
            asm volatile("s_waitcnt vmcnt(0)" ::: "memory");
            const unsigned og = xb_add(&bar[XB_TOP], 1u);
            const unsigned tg = og / nx;
            if (og + 1u == (tg + 1u) * nx) xb_add(&bar[XB_TOPGEN], 1u);
            else XB_SPIN(xb_ld(&bar[XB_TOPGEN]) == tg, bar);
            __builtin_amdgcn_fence(__ATOMIC_ACQUIRE, "agent");
            xb_add(&bar[XB_XGEN(b.x)], 1u);
            asm volatile("s_waitcnt vmcnt(0)" ::: "memory");
        } else {
            XB_SPIN(xb_ld(&bar[XB_XGEN(b.x)]) == gen, bar);
            __builtin_amdgcn_fence(__ATOMIC_ACQUIRE, "agent");
            asm volatile("s_waitcnt vmcnt(0)" ::: "memory");
        }
    }
    __syncthreads();
}


using pg8::bf16_t; using pg8::bf16x8; using pg8::f32x4; using pg8::u32x4; using pg8::cvt_pk_bf16;
typedef short bf16x4 __attribute__((ext_vector_type(4)));
typedef unsigned u32x2 __attribute__((ext_vector_type(2)));
constexpr int DM = 1024, TP = 16384, SB = 128, MT = TP + SB, SEQ = 2048, NBATCH = 8, NZ = 7168, NIN = 7184, NADA = 136;
constexpr int ZQ = 0, ZK = 512, ZV = 1024, ZG = 2048, ZCB = 3072, ZCC = 3584, ZCH = 4096, ZGC = 4608, ZMG = 5120, ZMC = 6144;
constexpr float QSCALE = 0.08838834764831845f, ALPHA = 1.4142135623730951f, EPS = 1e-5f;
constexpr int NTHR = 512, LDS_BYTES = 147456;
constexpr size_t SZ_WIN = (size_t)NZ * 1024 * 2, SZ_WPA = 1024 * 1024 * 2, SZ_WPB = 1024 * 512 * 2, SZ_WO = 1024 * 1024 * 2;
constexpr size_t OFF_CTL = 0, SZ_CTL = 65536;
constexpr size_t OFF_WIN = OFF_CTL + SZ_CTL, OFF_WPA = OFF_WIN + 2 * SZ_WIN, OFF_WPB = OFF_WPA + 2 * SZ_WPA, OFF_WO = OFF_WPB + 2 * SZ_WPB;
constexpr size_t OFF_ADA = OFF_WO + 2 * SZ_WO, SZ_ADA = (size_t)2 * NADA * 3072 * 4;
constexpr size_t OFF_U = OFF_ADA + SZ_ADA, SZ_U = (size_t)MT * 1024 * 2;
constexpr size_t OFF_Z = OFF_U + SZ_U, SZ_Z = (size_t)MT * NZ * 2;
constexpr size_t OFF_KST = OFF_Z + SZ_Z, SZ_KST = (size_t)MT * 512 * 2;
constexpr size_t OFF_B = OFF_KST + SZ_KST, SZ_B = (size_t)MT * 512 * 4;
constexpr size_t OFF_OG = OFF_B + SZ_B, SZ_OG = (size_t)MT * 1024 * 2;
constexpr size_t OFF_YC = OFF_OG + SZ_OG, SZ_YC = (size_t)MT * 512 * 2;
constexpr size_t OFF_Y1 = OFF_YC + SZ_YC, SZ_Y1 = (size_t)MT * 1024 * 4;
constexpr size_t WS_END = OFF_Y1 + SZ_Y1;
constexpr size_t OUT_Y = 0, OUT_GP = (size_t)MT * 1024, OUT_CP = OUT_GP + (size_t)2 * 8 * 4 * 128 * 256, OUT_GS = OUT_CP + 2 * 8 * 2 * 512, OUT_CS = OUT_GS + (size_t)2 * 128 * 4 * 128 * 256, OUT_END = OUT_CS + 2 * 128 * 2 * 512;

struct P {
    const float *xp, *xs, *cp, *cs, *sgla, *sconv, *w_ada, *b_ada, *w_in, *w_a2, *b_a, *gng, *conv_w, *w_pa, *w_pb, *w_o, *ln_g, *ln_b;
    float* out; unsigned char* ws; int ph_lo, ph_hi;
};
#define DI __device__ __forceinline__
DI bf16_t* wsb(const P& p, size_t off) { return (bf16_t*)(p.ws + off); }
DI float* wsf(const P& p, size_t off) { return (float*)(p.ws + off); }
DI float bf2f(unsigned short b) { return __uint_as_float(((unsigned)b) << 16); }
DI float bflo(unsigned w) { return __uint_as_float(w << 16); }
DI float bfhi(unsigned w) { return __uint_as_float(w & 0xffff0000u); }
DI unsigned short f2bf(float f) { return (unsigned short)(cvt_pk_bf16(f, 0.f) & 0xffffu); }
DI float sigmoidf_(float x) { return __builtin_amdgcn_rcpf(1.0f + __expf(-x)); }
DI float siluf_(float x) { return x * sigmoidf_(x); }
DI const float* xrow(const P& p, int l, int r) { return l == 0 ? (r < TP ? p.xp + (size_t)r * 1024 : p.xs + (size_t)(r - TP) * 1024) : wsf(p, OFF_Y1) + (size_t)r * 1024; }
DI int ada_row(int r) { return r < TP ? (r >> 11) : NBATCH + (r - TP); }
DI f32x4 mfma16(bf16x8 a, bf16x8 b, f32x4 c) { return __builtin_amdgcn_mfma_f32_16x16x32_bf16(a, b, c, 0, 0, 0); }
DI float wave_sum(float v) {
#pragma unroll
    for (int o = 32; o >= 1; o >>= 1) v += __shfl_xor(v, o);
    return v;
}

DI void p0_transpose_tile(const float* src, int ld, bf16_t* dst, int ldd, int k0, float* Ts, int tid) {
    {   const int kk = tid >> 4, n4 = (tid & 15) * 4;
#pragma unroll
        for (int e = 0; e < 2; ++e) { const int k = kk + 32 * e; const float4 v = *(const float4*)(src + (size_t)(k0 + k) * ld + n4);
            Ts[k * 65 + n4] = v.x; Ts[k * 65 + n4 + 1] = v.y; Ts[k * 65 + n4 + 2] = v.z; Ts[k * 65 + n4 + 3] = v.w; } }
    __syncthreads();
    {   const int n = tid >> 3, k8 = (tid & 7) * 8; u32x4 w;
        w.x = cvt_pk_bf16(Ts[(k8 + 0) * 65 + n], Ts[(k8 + 1) * 65 + n]); w.y = cvt_pk_bf16(Ts[(k8 + 2) * 65 + n], Ts[(k8 + 3) * 65 + n]);
        w.z = cvt_pk_bf16(Ts[(k8 + 4) * 65 + n], Ts[(k8 + 5) * 65 + n]); w.w = cvt_pk_bf16(Ts[(k8 + 6) * 65 + n], Ts[(k8 + 7) * 65 + n]);
        *(u32x4*)(dst + (size_t)n * ldd + k0 + k8) = w; }
    __syncthreads();
}
__device__ __forceinline__ void phase0(const P& p, unsigned char* sm) {
    const int tid = threadIdx.x + opaque_zero();
    float* Cs = (float*)sm;
    for (int it = blockIdx.x; it < 192; it += gridDim.x) {
        const int l = it / 96, n0 = (it % 96) * 32, c = tid & 31, rg = tid >> 5;
        const float* W = p.w_ada + (size_t)l * 1024 * 3072 + n0 + c;
        float acc[9];
#pragma unroll
        for (int i = 0; i < 9; ++i) acc[i] = 0.f;
        for (int kc = 0; kc < 1024; kc += 128) {
            __syncthreads();
            for (int e = tid; e < NADA * 32; e += NTHR) { const int row = e >> 5, k4 = (e & 31) * 4;
                const float* src = row < NBATCH ? p.cp + (size_t)row * 1024 : p.cs + (size_t)(row - NBATCH) * 1024;
                *(float4*)(Cs + row * 132 + k4) = *(const float4*)(src + kc + k4); }
            __syncthreads();
#pragma unroll 2
            for (int k4 = 0; k4 < 128; k4 += 4) {
                const float w0 = W[(size_t)(kc + k4) * 3072], w1 = W[(size_t)(kc + k4 + 1) * 3072], w2 = W[(size_t)(kc + k4 + 2) * 3072], w3 = W[(size_t)(kc + k4 + 3) * 3072];
#pragma unroll
                for (int i = 0; i < 9; ++i) { const int row = rg + 16 * i; if (row < NADA) { const float4 cv = *(const float4*)(Cs + row * 132 + k4);
                    acc[i] = fmaf(cv.x, w0, fmaf(cv.y, w1, fmaf(cv.z, w2, fmaf(cv.w, w3, acc[i])))); } }
            }
        }
        const float bb = p.b_ada[l * 3072 + n0 + c];
#pragma unroll
        for (int i = 0; i < 9; ++i) { const int row = rg + 16 * i; if (row < NADA) wsf(p, OFF_ADA)[((size_t)l * NADA + row) * 3072 + n0 + c] = acc[i] + bb; }
    }
    __syncthreads();
    float* Ts = (float*)sm;
    for (int t = blockIdx.x; t < 2 * 2432; t += gridDim.x) {
        const int l = t / 2432; int u = t % 2432;
        if (u < 1792) { const int kt = u & 15, nt = u >> 4, n0 = nt * 64, sc = n0 < 3072 ? n0 : n0 + 16;
            p0_transpose_tile(p.w_in + (size_t)l * 1024 * NIN + sc, NIN, wsb(p, OFF_WIN + l * SZ_WIN) + (size_t)n0 * 1024, 1024, kt * 64, Ts, tid); }
        else if (u < 2048) { u -= 1792; const int kt = u & 15, nt = u >> 4;
            p0_transpose_tile(p.w_pa + (size_t)l * 1024 * 1024 + nt * 64, 1024, wsb(p, OFF_WPA + l * SZ_WPA) + (size_t)nt * 64 * 1024, 1024, kt * 64, Ts, tid); }
        else if (u < 2176) { u -= 2048; const int kt = u & 7, nt = u >> 3;
            p0_transpose_tile(p.w_pb + (size_t)l * 512 * 1024 + nt * 64, 1024, wsb(p, OFF_WPB + l * SZ_WPB) + (size_t)nt * 64 * 512, 512, kt * 64, Ts, tid); }
        else { u -= 2176; const int kt = u & 15, nt = u >> 4;
            p0_transpose_tile(p.w_o + (size_t)l * 1024 * 1024 + nt * 64, 1024, wsb(p, OFF_WO + l * SZ_WO) + (size_t)nt * 64 * 1024, 1024, kt * 64, Ts, tid); }
    }
}

__device__ __forceinline__ void phase1(const P& p, unsigned char* sm, int l, int mode) {
    const int tid = threadIdx.x + opaque_zero(), w = tid >> 6, lane = tid & 63;
    float* WaT = (float*)sm;
    float* ALR = (float*)(sm + 65536);
    if (mode != 2) {
        const float* wsrc = p.w_in + (size_t)l * 1024 * NIN + 3072;
        for (int e = tid; e < 16384; e += NTHR) { const int k = e >> 4, r = e & 15; WaT[r * 1024 + k] = wsrc[(size_t)k * NIN + r]; }
    }
    __syncthreads();
    const float* R = wsf(p, OFF_Z);
    const int lnl = (mode == 1) ? l - 1 : l;
    float* ydst = (mode == 1) ? wsf(p, OFF_Y1) : p.out + OUT_Y;
    for (int it = blockIdx.x; it < MT / 64; it += gridDim.x) {
        for (int rr = 0; rr < 8; ++rr) {
            const int i = w * 8 + rr, r = it * 64 + i;
            float4 xv[4];
            if (mode == 0) { const float* src = xrow(p, 0, r);
#pragma unroll
                for (int q = 0; q < 4; ++q) xv[q] = *(const float4*)(src + 256 * q + 4 * lane); }
            else { const float* src = R + (size_t)r * 1024;
#pragma unroll
                for (int q = 0; q < 4; ++q) xv[q] = *(const float4*)(src + 256 * q + 4 * lane);
                float s = 0.f;
#pragma unroll
                for (int q = 0; q < 4; ++q) s += xv[q].x + xv[q].y + xv[q].z + xv[q].w;
                const float mean = wave_sum(s) * (1.0f / 1024.0f);
                float vs = 0.f;
#pragma unroll
                for (int q = 0; q < 4; ++q) { xv[q].x -= mean; xv[q].y -= mean; xv[q].z -= mean; xv[q].w -= mean; vs += xv[q].x * xv[q].x + xv[q].y * xv[q].y + xv[q].z * xv[q].z + xv[q].w * xv[q].w; }
                const float rstd = rsqrtf(wave_sum(vs) * (1.0f / 1024.0f) + EPS);
#pragma unroll
                for (int q = 0; q < 4; ++q) { const float4 g = *(const float4*)(p.ln_g + lnl * 1024 + 256 * q + 4 * lane), bb = *(const float4*)(p.ln_b + lnl * 1024 + 256 * q + 4 * lane);
                    xv[q].x = xv[q].x * rstd * g.x + bb.x; xv[q].y = xv[q].y * rstd * g.y + bb.y; xv[q].z = xv[q].z * rstd * g.z + bb.z; xv[q].w = xv[q].w * rstd * g.w + bb.w;
                    *(float4*)(ydst + (size_t)r * 1024 + 256 * q + 4 * lane) = xv[q]; }
            }
            if (mode == 2) continue;
            const float* ada = wsf(p, OFF_ADA) + ((size_t)l * NADA + ada_row(r)) * 3072;
            float pa[16];
#pragma unroll
            for (int j = 0; j < 16; ++j) pa[j] = 0.f;
#pragma unroll
            for (int q = 0; q < 4; ++q) { const int c = 256 * q + 4 * lane; const float4 sh = *(const float4*)(ada + c), sc = *(const float4*)(ada + 1024 + c);
                float4 u; u.x = xv[q].x * (1.0f + sc.x) + sh.x; u.y = xv[q].y * (1.0f + sc.y) + sh.y; u.z = xv[q].z * (1.0f + sc.z) + sh.z; u.w = xv[q].w * (1.0f + sc.w) + sh.w;
                u32x2 pk; pk.x = cvt_pk_bf16(u.x, u.y); pk.y = cvt_pk_bf16(u.z, u.w);
                *(u32x2*)(wsb(p, OFF_U) + (size_t)r * 1024 + c) = pk;
#pragma unroll
                for (int j = 0; j < 16; ++j) { const float4 wv = *(const float4*)(WaT + j * 1024 + c); pa[j] = fmaf(u.x, wv.x, fmaf(u.y, wv.y, fmaf(u.z, wv.z, fmaf(u.w, wv.w, pa[j])))); } }
            float p8[8], p4[4], p2[2], p1;
            { const bool b = lane & 32;
#pragma unroll
              for (int j = 0; j < 8; ++j) { const float keep = b ? pa[j + 8] : pa[j], send = b ? pa[j] : pa[j + 8]; p8[j] = keep + __shfl_xor(send, 32); } }
            { const bool b = lane & 16;
#pragma unroll
              for (int j = 0; j < 4; ++j) { const float keep = b ? p8[j + 4] : p8[j], send = b ? p8[j] : p8[j + 4]; p4[j] = keep + __shfl_xor(send, 16); } }
            { const bool b = lane & 8;
#pragma unroll
              for (int j = 0; j < 2; ++j) { const float keep = b ? p4[j + 2] : p4[j], send = b ? p4[j] : p4[j + 2]; p2[j] = keep + __shfl_xor(send, 8); } }
            { const bool b = lane & 4; const float keep = b ? p2[1] : p2[0], send = b ? p2[0] : p2[1]; p1 = keep + __shfl_xor(send, 4); }
            p1 += __shfl_xor(p1, 1); p1 += __shfl_xor(p1, 2);
            if ((lane & 3) == 0) { const int r16 = 8 * ((lane >> 5) & 1) + 4 * ((lane >> 4) & 1) + 2 * ((lane >> 3) & 1) + ((lane >> 2) & 1); ALR[i * 16 + r16] = p1; }
        }
        if (mode == 2) continue;
        __syncthreads();
        {
            float w2[16];
#pragma unroll
            for (int j = 0; j < 16; ++j) w2[j] = p.w_a2[((size_t)l * 16 + j) * 512 + tid];
            const float ba = p.b_a[l * 512 + tid];
            const bool prompt = it < TP / 64;
            float run = 0.f; float* Bc = wsf(p, OFF_B) + (size_t)it * 64 * 512 + tid;
            for (int i = 0; i < 64; ++i) {
                float x = ba;
#pragma unroll
                for (int j4 = 0; j4 < 4; ++j4) { const float4 a = *(const float4*)(ALR + i * 16 + 4 * j4); x = fmaf(a.x, w2[4 * j4], fmaf(a.y, w2[4 * j4 + 1], fmaf(a.z, w2[4 * j4 + 2], fmaf(a.w, w2[4 * j4 + 3], x)))); }
                const float la = (fminf(x, 0.f) - __logf(1.0f + __expf(-fabsf(x)))) * (1.0f / 16.0f);
                run = prompt ? run + la : la;
                Bc[(size_t)i * 512] = run;
            }
        }
        __syncthreads();
    }
}

DI void in_elem(const P& p, int r, int c, float v) {
    bf16_t* Z = wsb(p, OFF_Z); const float* Bc = wsf(p, OFF_B);
    if (c < 512) { Z[(size_t)r * NZ + c] = f2bf(v * QSCALE * __expf(Bc[(size_t)r * 512 + c])); }
    else if (c < 1024) { const int cc = c - 512; const float b = Bc[(size_t)r * 512 + cc], bl = r < TP ? Bc[(size_t)(r | 63) * 512 + cc] : b;
        Z[(size_t)r * NZ + c] = f2bf(v * __expf(-b)); wsb(p, OFF_KST)[(size_t)r * 512 + cc] = f2bf(v * __expf(bl - b)); }
    else Z[(size_t)r * NZ + c] = f2bf(v);
}
struct EpiIn {
    static constexpr bool PERM = true, AFTER_DRAIN = false;
    bf16_t* Z; bf16_t* KST; const float* Bc;
    __device__ __forceinline__ void operator()(const f32x4 (&acc)[2][2][4][2], const pg8::Unit& u, int wr, int wc, int fr, int fq) const {
        const int row0 = u.pm * 256 + wr * 64 + fr + opaque_zero(), colt = u.pn * 256, col0 = colt + wc * 32 + 8 * fq;
#pragma unroll
        for (int ai = 0; ai < 2; ++ai)
#pragma unroll
            for (int m = 0; m < 4; ++m) { const int r = row0 + ai * 128 + m * 16;
#pragma unroll
                for (int bj = 0; bj < 2; ++bj) { const int c = col0 + bj * 128; f32x4 v0 = acc[ai][bj][m][0], v1 = acc[ai][bj][m][1];
                    if (colt < 512) { const f32x4 b0 = *(const f32x4*)(Bc + (size_t)r * 512 + c), b1 = *(const f32x4*)(Bc + (size_t)r * 512 + c + 4);
#pragma unroll
                        for (int j = 0; j < 4; ++j) { v0[j] *= QSCALE * __expf(b0[j]); v1[j] *= QSCALE * __expf(b1[j]); } }
                    else if (colt < 1024) { const int cc = c - 512;
                        const f32x4 b0 = *(const f32x4*)(Bc + (size_t)r * 512 + cc), b1 = *(const f32x4*)(Bc + (size_t)r * 512 + cc + 4);
                        const f32x4 l0 = *(const f32x4*)(Bc + (size_t)(r | 63) * 512 + cc), l1 = *(const f32x4*)(Bc + (size_t)(r | 63) * 512 + cc + 4);
                        u32x4 ws_; ws_.x = cvt_pk_bf16(v0[0] * __expf(l0[0] - b0[0]), v0[1] * __expf(l0[1] - b0[1])); ws_.y = cvt_pk_bf16(v0[2] * __expf(l0[2] - b0[2]), v0[3] * __expf(l0[3] - b0[3]));
                        ws_.z = cvt_pk_bf16(v1[0] * __expf(l1[0] - b1[0]), v1[1] * __expf(l1[1] - b1[1])); ws_.w = cvt_pk_bf16(v1[2] * __expf(l1[2] - b1[2]), v1[3] * __expf(l1[3] - b1[3]));
                        *(u32x4*)(KST + (size_t)r * 512 + cc) = ws_;
#pragma unroll
                        for (int j = 0; j < 4; ++j) { v0[j] *= __expf(-b0[j]); v1[j] *= __expf(-b1[j]); } }
                    u32x4 w; w.x = cvt_pk_bf16(v0[0], v0[1]); w.y = cvt_pk_bf16(v0[2], v0[3]); w.z = cvt_pk_bf16(v1[0], v1[1]); w.w = cvt_pk_bf16(v1[2], v1[3]);
                    *(u32x4*)(Z + (size_t)r * NZ + c) = w; __builtin_amdgcn_sched_barrier(0); } }
    }
};
template <int SECOND> struct EpiMerge {
    static constexpr bool PERM = true, AFTER_DRAIN = false;
    bf16_t* MG; const bf16_t* Z;
    __device__ __forceinline__ void operator()(const f32x4 (&acc)[2][2][4][2], const pg8::Unit& u, int wr, int wc, int fr, int fq) const {
        const int row0 = u.pm * 256 + wr * 64 + fr + opaque_zero(), col0 = u.pn * 256 + wc * 32 + 8 * fq;
#pragma unroll
        for (int ai = 0; ai < 2; ++ai)
#pragma unroll
            for (int m = 0; m < 4; ++m) { const int r = row0 + ai * 128 + m * 16;
#pragma unroll
                for (int bj = 0; bj < 2; ++bj) { const int c = col0 + bj * 128; const f32x4 v0 = acc[ai][bj][m][0], v1 = acc[ai][bj][m][1];
                    const u32x4 g = *(const u32x4*)(Z + (size_t)r * NZ + (SECOND ? ZMC : ZMG) + c);
                    float o[8];
                    o[0] = v0[0] * sigmoidf_(bflo(g.x)); o[1] = v0[1] * sigmoidf_(bfhi(g.x)); o[2] = v0[2] * sigmoidf_(bflo(g.y)); o[3] = v0[3] * sigmoidf_(bfhi(g.y));
                    o[4] = v1[0] * sigmoidf_(bflo(g.z)); o[5] = v1[1] * sigmoidf_(bfhi(g.z)); o[6] = v1[2] * sigmoidf_(bflo(g.w)); o[7] = v1[3] * sigmoidf_(bfhi(g.w));
                    if (SECOND) { const u32x4 t = *(const u32x4*)(MG + (size_t)r * 1024 + c);
                        o[0] += bflo(t.x); o[1] += bfhi(t.x); o[2] += bflo(t.y); o[3] += bfhi(t.y); o[4] += bflo(t.z); o[5] += bfhi(t.z); o[6] += bflo(t.w); o[7] += bfhi(t.w); }
                    u32x4 w; w.x = cvt_pk_bf16(o[0], o[1]); w.y = cvt_pk_bf16(o[2], o[3]); w.z = cvt_pk_bf16(o[4], o[5]); w.w = cvt_pk_bf16(o[6], o[7]);
                    *(u32x4*)(MG + (size_t)r * 1024 + c) = w; __builtin_amdgcn_sched_barrier(0); } }
    }
};
struct EpiRes {
    static constexpr bool PERM = false, AFTER_DRAIN = false;
    float* R; const float* X; const float* ada;
    __device__ __forceinline__ void operator()(const f32x4 (&acc)[2][2][4][2], const pg8::Unit& u, int wr, int wc, int fr, int fq) const {
        const int row0 = u.pm * 256 + wr * 64 + fr + opaque_zero(), col0 = u.pn * 256 + wc * 32 + 4 * fq;
        const float* gate = ada + (size_t)(u.pm >> 3) * 3072 + 2048;
        f32x4 gv[2][2];
#pragma unroll
        for (int bj = 0; bj < 2; ++bj)
#pragma unroll
            for (int n = 0; n < 2; ++n) gv[bj][n] = *(const f32x4*)(gate + col0 + bj * 128 + n * 16);
#pragma unroll
        for (int ai = 0; ai < 2; ++ai)
#pragma unroll
            for (int m = 0; m < 4; ++m) { const size_t ro = (size_t)(row0 + ai * 128 + m * 16) * 1024 + col0;
#pragma unroll
                for (int bj = 0; bj < 2; ++bj)
#pragma unroll
                    for (int n = 0; n < 2; ++n) { const f32x4 xv = *(const f32x4*)(X + ro + bj * 128 + n * 16);
                        *(f32x4*)(R + ro + bj * 128 + n * 16) = xv * ALPHA + gv[bj][n] * acc[ai][bj][m][n]; } __builtin_amdgcn_sched_barrier(0); }
    }
};
DI f32x4 small_mma(const bf16_t* A, int lda, const bf16_t* Bt, int K, int arow0, int n0, int fr, int fq) {
    f32x4 acc = {0.f, 0.f, 0.f, 0.f};
    const bf16_t* ap = A + (size_t)(arow0 + fr) * lda + 8 * fq; const bf16_t* bp = Bt + (size_t)(n0 + fr) * K + 8 * fq;
#pragma unroll 8
    for (int k = 0; k < K; k += 32) acc = mfma16(*(const bf16x8*)(ap + k), *(const bf16x8*)(bp + k), acc);
    return acc;
}

__device__ __forceinline__ void phase2(const P& p, unsigned char* sm, int l) {
    {   pg8::Gemm g; g.A = wsb(p, OFF_U); g.Bt = wsb(p, OFF_WIN + l * SZ_WIN); g.M = TP; g.N = NZ; g.K = 1024;
        pg8::StaticOrder S; S.init(TP, NZ, (int)gridDim.x, (int)blockIdx.x);
        EpiIn E; E.Z = wsb(p, OFF_Z); E.KST = wsb(p, OFF_KST); E.Bc = wsf(p, OFF_B);
        pg8::gemm_phase<EpiIn, pg8::StaticOrder, false>((LAS unsigned char*)sm, g, S, E, nullptr); }
    const int tid = threadIdx.x + opaque_zero(), w = tid >> 6, lane = tid & 63, fr = lane & 15, fq = lane >> 4;
    for (int it = blockIdx.x; it < NZ / 16; it += gridDim.x) {
        const f32x4 a = small_mma(wsb(p, OFF_U) + (size_t)TP * 1024, 1024, wsb(p, OFF_WIN + l * SZ_WIN), 1024, 16 * w, it * 16, fr, fq);
#pragma unroll
        for (int j = 0; j < 4; ++j) in_elem(p, TP + 16 * w + 4 * fq + j, it * 16 + fr, a[j]);
    }
}
__device__ __forceinline__ void phase4(const P& p, unsigned char* sm, int l) {
    bf16_t* MG = wsb(p, OFF_U);
    {   pg8::Gemm g; g.A = wsb(p, OFF_OG); g.Bt = wsb(p, OFF_WPA + l * SZ_WPA); g.M = TP; g.N = 1024; g.K = 1024;
        pg8::StaticOrder S; S.init(TP, 1024, (int)gridDim.x, (int)blockIdx.x);
        EpiMerge<0> E; E.MG = MG; E.Z = wsb(p, OFF_Z);
        pg8::gemm_phase<EpiMerge<0>, pg8::StaticOrder, false>((LAS unsigned char*)sm, g, S, E, nullptr); }
    asm volatile("s_waitcnt vmcnt(0)" ::: "memory"); __syncthreads();
    {   const int oz = opaque_zero(); pg8::Gemm g; g.A = wsb(p, OFF_YC) + oz; g.Bt = wsb(p, OFF_WPB + l * SZ_WPB) + oz; g.M = TP; g.N = 1024; g.K = 512 + oz; MG += oz;
        pg8::StaticOrder S; S.init(TP, 1024, (int)gridDim.x, (int)blockIdx.x);
        EpiMerge<1> E; E.MG = MG; E.Z = wsb(p, OFF_Z);
        pg8::gemm_phase<EpiMerge<1>, pg8::StaticOrder, false>((LAS unsigned char*)sm, g, S, E, nullptr); }
    const int tid = threadIdx.x + opaque_zero(), w = tid >> 6, lane = tid & 63, fr = lane & 15, fq = lane >> 4;
    for (int it = blockIdx.x; it < 64; it += gridDim.x) {
        const f32x4 a = small_mma(wsb(p, OFF_OG) + (size_t)TP * 1024, 1024, wsb(p, OFF_WPA + l * SZ_WPA), 1024, 16 * w, it * 16, fr, fq);
        const f32x4 b = small_mma(wsb(p, OFF_YC) + (size_t)TP * 512, 512, wsb(p, OFF_WPB + l * SZ_WPB), 512, 16 * w, it * 16, fr, fq);
#pragma unroll
        for (int j = 0; j < 4; ++j) { const int r = TP + 16 * w + 4 * fq + j, c = it * 16 + fr; const bf16_t* z = wsb(p, OFF_Z) + (size_t)r * NZ;
            MG[(size_t)r * 1024 + c] = f2bf(sigmoidf_(bf2f(z[ZMG + c])) * a[j] + sigmoidf_(bf2f(z[ZMC + c])) * b[j]); }
    }
}
__device__ __forceinline__ void phase5(const P& p, unsigned char* sm, int l) {
    float* R = wsf(p, OFF_Z); const float* ada = wsf(p, OFF_ADA) + (size_t)l * NADA * 3072;
    {   pg8::Gemm g; g.A = wsb(p, OFF_U); g.Bt = wsb(p, OFF_WO + l * SZ_WO); g.M = TP; g.N = 1024; g.K = 1024;
        pg8::StaticOrder S; S.init(TP, 1024, (int)gridDim.x, (int)blockIdx.x);
        EpiRes E; E.R = R; E.X = (l == 0) ? p.xp : wsf(p, OFF_Y1); E.ada = ada;
        pg8::gemm_phase<EpiRes, pg8::StaticOrder, false>((LAS unsigned char*)sm, g, S, E, nullptr); }
    const int tid = threadIdx.x + opaque_zero(), w = tid >> 6, lane = tid & 63, fr = lane & 15, fq = lane >> 4;
#ifndef NO_SMALL
    for (int it = blockIdx.x; it < 64; it += gridDim.x) {
        const f32x4 a = small_mma(wsb(p, OFF_U) + (size_t)TP * 1024, 1024, wsb(p, OFF_WO + l * SZ_WO), 1024, 16 * w, it * 16, fr, fq);
#pragma unroll
        for (int j = 0; j < 4; ++j) { const int r = TP + 16 * w + 4 * fq + j, c = it * 16 + fr;
            R[(size_t)r * 1024 + c] = ALPHA * xrow(p, l, r)[c] + ada[(size_t)ada_row(r) * 3072 + 2048 + c] * a[j]; }
    }
#endif
}

DI bf16x8 cat8(u32x2 lo, u32x2 hi) { u32x4 v; v.x = lo.x; v.y = lo.y; v.z = hi.x; v.w = hi.y; return __builtin_bit_cast(bf16x8, v); }
__device__ __forceinline__ void gla_prompt(const P& p, unsigned char* sm, int l, int b, int h) {
    const int tid = threadIdx.x + opaque_zero(), w = tid >> 6, lane = tid & 63, fr = lane & 15, fq = lane >> 4;
    LAS unsigned char* L = (LAS unsigned char*)sm;
    constexpr int oQS = 0, oKI = 17408, oKT = 34816, oVT = 53248, oAT = 90112, oRS = 99328, oDEC = 101376, oRSTD = 101888;
    const bf16_t* Z = wsb(p, OFF_Z); const bf16_t* KST = wsb(p, OFF_KST); const float* Bc = wsf(p, OFF_B); bf16_t* OG = wsb(p, OFF_OG);
    const size_t rowb = (size_t)b * SEQ;
    const int qa = (fr * 136 + 8 * fq) * 2;
    const int qp = (fr * 136 + 4 * fq) * 2;
    const int tb = (fr * 72 + 8 * fq) * 2;
    const int fQ = ((tid >> 4) * 136 + (tid & 15) * 8) * 2;
    const int fT = ((tid >> 6) * 8 * 72 + (tid & 63)) * 2;
    f32x4 S[8][2];
#pragma unroll
    for (int kt = 0; kt < 8; ++kt) { S[kt][0] = (f32x4){0.f, 0.f, 0.f, 0.f}; S[kt][1] = (f32x4){0.f, 0.f, 0.f, 0.f}; }
    const float gn0 = p.gng[l * 256 + 32 * w + fr], gn1 = p.gng[l * 256 + 32 * w + 16 + fr];
    u32x4 rq[2], rk[2], rs[2], rv[4], rg[4]; float rdec = 0.f;
#define GLA_LOAD(n) do { const size_t ro_ = (size_t)(n) * 64; \
        _Pragma("unroll") for (int e = 0; e < 2; ++e) { rq[e] = *(const u32x4*)(gq + (ro_ + 32 * e) * NZ); rk[e] = *(const u32x4*)(gq + (ro_ + 32 * e) * NZ + (ZK - ZQ)); } \
        _Pragma("unroll") for (int e = 0; e < 2; ++e) rs[e] = *(const u32x4*)(gs + ro_ * 512 + 64 * e); \
        _Pragma("unroll") for (int e = 0; e < 4; ++e) rv[e] = *(const u32x4*)(gv + ro_ * NZ + 64 * e); \
        if (tid < 128) rdec = gd[ro_ * 512]; } while (0)
#define GLA_TW(off, vec) do { const u32x4 v_ = (vec); \
        *(LAS bf16_t*)(L + (off) + 0 * 144) = (bf16_t)(v_.x & 0xffffu); *(LAS bf16_t*)(L + (off) + 1 * 144) = (bf16_t)(v_.x >> 16); *(LAS bf16_t*)(L + (off) + 2 * 144) = (bf16_t)(v_.y & 0xffffu); *(LAS bf16_t*)(L + (off) + 3 * 144) = (bf16_t)(v_.y >> 16); \
        *(LAS bf16_t*)(L + (off) + 4 * 144) = (bf16_t)(v_.z & 0xffffu); *(LAS bf16_t*)(L + (off) + 5 * 144) = (bf16_t)(v_.z >> 16); *(LAS bf16_t*)(L + (off) + 6 * 144) = (bf16_t)(v_.w & 0xffffu); *(LAS bf16_t*)(L + (off) + 7 * 144) = (bf16_t)(v_.w >> 16); } while (0)
#define GLA_FILL() do { \
        _Pragma("unroll") for (int e = 0; e < 2; ++e) { *(LAS u32x4*)(L + oQS + fQ + e * 32 * 272) = rq[e]; *(LAS u32x4*)(L + oKI + fQ + e * 32 * 272) = rk[e]; } \
        _Pragma("unroll") for (int e = 0; e < 2; ++e) GLA_TW(oKT + fT + e * 64 * 144, rs[e]); \
        _Pragma("unroll") for (int e = 0; e < 4; ++e) GLA_TW(oVT + fT + e * 64 * 144, rv[e]); \
        if (tid < 128) *(LAS float*)(L + oDEC + tid * 4) = __expf(rdec); } while (0)
    for (int n = 0; n < SEQ / 64; ++n) {
        const int t2 = tid + opaque_zero(); const size_t rown = rowb + (size_t)n * 64;
        const bf16_t* gq = Z + (rown + (t2 >> 4)) * NZ + ZQ + h * 128 + (t2 & 15) * 8;
        const bf16_t* gs = KST + (rown + (t2 & 63)) * 512 + h * 128 + (t2 >> 6) * 8;
        const bf16_t* gv = Z + (rown + (t2 & 63)) * NZ + ZV + h * 256 + (t2 >> 6) * 8;
        const bf16_t* gg = Z + (rown + (t2 >> 5)) * NZ + ZG + h * 256 + (t2 & 31) * 8;
        bf16_t* go = OG + (rown + (t2 >> 5)) * 1024 + h * 256 + (t2 & 31) * 8;
        const float* gd = Bc + (rown + 63) * 512 + h * 128 + (t2 & 127);
        __syncthreads();
        GLA_LOAD(0); GLA_FILL();
        __syncthreads();
        __builtin_amdgcn_sched_barrier(0);
        {   const int it = w >> 1;
#pragma unroll
            for (int jj = 0; jj < 2; ++jj) { const int jt = (w & 1) * 2 + jj; f32x4 a = {0.f, 0.f, 0.f, 0.f};
                if (jt <= it) {
#pragma unroll
                    for (int ks = 0; ks < 4; ++ks) a = mfma16(*(const LAS bf16x8*)(L + oQS + qa + it * 16 * 272 + ks * 64), *(const LAS bf16x8*)(L + oKI + qa + jt * 16 * 272 + ks * 64), a); }
#pragma unroll
                for (int e = 0; e < 4; ++e) { const int i = it * 16 + 4 * fq + e, j = jt * 16 + fr; *(LAS bf16_t*)(L + oAT + (i * 72 + j) * 2) = (j <= i) ? f2bf(a[e]) : (bf16_t)0; } } }
#pragma unroll
        for (int e = 0; e < 4; ++e) rg[e] = *(const u32x4*)(gg + (size_t)(16 * e) * NZ);
        __syncthreads();
        __builtin_amdgcn_sched_barrier(0);
        f32x4 o[4][2];
#pragma unroll
        for (int it = 0; it < 4; ++it) { o[it][0] = (f32x4){0.f, 0.f, 0.f, 0.f}; o[it][1] = (f32x4){0.f, 0.f, 0.f, 0.f}; }
        bf16x8 vb[2][2];
#pragma unroll
        for (int nt = 0; nt < 2; ++nt)
#pragma unroll
            for (int js = 0; js < 2; ++js) vb[nt][js] = *(const LAS bf16x8*)(L + oVT + tb + (32 * w + nt * 16) * 144 + js * 64);
#pragma unroll
        for (int it = 0; it < 4; ++it)
#pragma unroll
            for (int js = 0; js < 2; ++js) { if (js == 1 && it < 2) continue;
                const bf16x8 a = *(const LAS bf16x8*)(L + oAT + tb + it * 16 * 144 + js * 64);
                o[it][0] = mfma16(a, vb[0][js], o[it][0]); o[it][1] = mfma16(a, vb[1][js], o[it][1]); }
#pragma unroll
        for (int ks = 0; ks < 4; ++ks) { bf16x8 sb[2];
#pragma unroll
            for (int nt = 0; nt < 2; ++nt) { u32x4 t; t.x = cvt_pk_bf16(S[2 * ks][nt][0], S[2 * ks][nt][1]); t.y = cvt_pk_bf16(S[2 * ks][nt][2], S[2 * ks][nt][3]);
                t.z = cvt_pk_bf16(S[2 * ks + 1][nt][0], S[2 * ks + 1][nt][1]); t.w = cvt_pk_bf16(S[2 * ks + 1][nt][2], S[2 * ks + 1][nt][3]); sb[nt] = __builtin_bit_cast(bf16x8, t); }
#pragma unroll
            for (int it = 0; it < 4; ++it) {
                const bf16x8 a = cat8(*(const LAS u32x2*)(L + oQS + qp + it * 16 * 272 + ks * 64), *(const LAS u32x2*)(L + oQS + qp + it * 16 * 272 + ks * 64 + 32));
                o[it][0] = mfma16(a, sb[0], o[it][0]); o[it][1] = mfma16(a, sb[1], o[it][1]); }
            __builtin_amdgcn_sched_barrier(0); }
        __builtin_amdgcn_sched_barrier(0);
#pragma unroll
        for (int it = 0; it < 4; ++it)
#pragma unroll
            for (int e = 0; e < 4; ++e) { float s = o[it][0][e] * o[it][0][e] + o[it][1][e] * o[it][1][e];
                s += __shfl_xor(s, 1); s += __shfl_xor(s, 2); s += __shfl_xor(s, 4); s += __shfl_xor(s, 8);
                if (fr == 0) *(LAS float*)(L + oRS + (w * 64 + it * 16 + 4 * fq + e) * 4) = s; }
        __syncthreads();
        if (tid < 64) { float s = 0.f;
#pragma unroll
            for (int ww = 0; ww < 8; ++ww) s += *(const LAS float*)(L + oRS + (ww * 64 + tid) * 4);
            *(LAS float*)(L + oRSTD + tid * 4) = rsqrtf(s * (1.0f / 256.0f) + EPS); }
        __syncthreads();
#pragma unroll
        for (int it = 0; it < 4; ++it) { const f32x4 rsd = *(const LAS f32x4*)(L + oRSTD + (it * 16 + 4 * fq) * 4);
#pragma unroll
            for (int e = 0; e < 4; ++e) { const int i = it * 16 + 4 * fq + e;
                *(LAS bf16_t*)(L + (i * 264 + 32 * w + fr) * 2) = f2bf(o[it][0][e] * rsd[e] * gn0); *(LAS bf16_t*)(L + (i * 264 + 32 * w + 16 + fr) * 2) = f2bf(o[it][1][e] * rsd[e] * gn1); } }
        __syncthreads();
#pragma unroll
        for (int e = 0; e < 4; ++e) { const u32x4 ov = *(const LAS u32x4*)(L + (((tid >> 5) + 16 * e) * 264 + (tid & 31) * 8) * 2); const u32x4 g = rg[e];
            u32x4 r; r.x = cvt_pk_bf16(bflo(ov.x) * siluf_(bflo(g.x)), bfhi(ov.x) * siluf_(bfhi(g.x))); r.y = cvt_pk_bf16(bflo(ov.y) * siluf_(bflo(g.y)), bfhi(ov.y) * siluf_(bfhi(g.y)));
            r.z = cvt_pk_bf16(bflo(ov.z) * siluf_(bflo(g.z)), bfhi(ov.z) * siluf_(bfhi(g.z))); r.w = cvt_pk_bf16(bflo(ov.w) * siluf_(bflo(g.w)), bfhi(ov.w) * siluf_(bfhi(g.w)));
            *(u32x4*)(go + (size_t)(16 * e) * 1024) = r; }
        __builtin_amdgcn_sched_barrier(0);
#pragma unroll
        for (int kt = 0; kt < 8; ++kt) { const f32x4 d = *(const LAS f32x4*)(L + oDEC + (kt * 16 + 4 * fq) * 4);
            S[kt][0] *= d; S[kt][1] *= d;
#pragma unroll
            for (int js = 0; js < 2; ++js) { const bf16x8 a = *(const LAS bf16x8*)(L + oKT + tb + kt * 16 * 144 + js * 64);
                S[kt][0] = mfma16(a, vb[0][js], S[kt][0]); S[kt][1] = mfma16(a, vb[1][js], S[kt][1]); }
            if (kt & 1) __builtin_amdgcn_sched_barrier(0); }
    }
    __syncthreads();
    {   const int sbase = ((4 * fq) * 256 + 32 * w + fr) * 4;
#pragma unroll
        for (int kt = 0; kt < 8; ++kt)
#pragma unroll
            for (int nt = 0; nt < 2; ++nt)
#pragma unroll
                for (int e = 0; e < 4; ++e) *(LAS float*)(L + sbase + ((kt * 16 + e) * 256 + nt * 16) * 4) = S[kt][nt][e];
    }
    __syncthreads();
    {   f32x4* So = (f32x4*)(p.out + OUT_GP + (((size_t)l * NBATCH + b) * 4 + h) * 128 * 256);
#pragma unroll 1
        for (int i = tid; i < 8192; i += NTHR) So[i] = *(const LAS f32x4*)(L + i * 16);
    }
#undef GLA_LOAD
#undef GLA_TW
#undef GLA_FILL
}
__device__ __forceinline__ void p3_other(const P& p, unsigned char* sm, int l, int first, int nblk) {
    const int tid = threadIdx.x + opaque_zero(), w = tid >> 6, lane = tid & 63;
    float* qf = (float*)sm; float* kif = qf + 128; float* ksf = kif + 128; float* af = ksf + 128; float* vf = af + 128; float* OP = vf + 256; float* red = OP + 2048;
    const bf16_t* Z = wsb(p, OFF_Z);
    for (int it = (int)blockIdx.x - first; it < 512 + 258; it += nblk) {
        if (it < 512) {
            const int sb = it >> 2, h = it & 3, r = TP + sb;
            __syncthreads();
            if (tid < 128) { qf[tid] = bf2f(Z[(size_t)r * NZ + ZQ + h * 128 + tid]); kif[tid] = bf2f(Z[(size_t)r * NZ + ZK + h * 128 + tid]);
                ksf[tid] = bf2f(wsb(p, OFF_KST)[(size_t)r * 512 + h * 128 + tid]); af[tid] = __expf(wsf(p, OFF_B)[(size_t)r * 512 + h * 128 + tid]); }
            else if (tid < 384) vf[tid - 128] = bf2f(Z[(size_t)r * NZ + ZV + h * 256 + tid - 128]);
            __syncthreads();
            const float* S0 = p.sgla + ((((size_t)l * SB + sb) * 4 + h) * 128) * 256; float* S1 = p.out + OUT_GS + ((((size_t)l * SB + sb) * 4 + h) * 128) * 256;
            const float4 v4 = *(const float4*)(vf + 4 * lane); float4 op = {0.f, 0.f, 0.f, 0.f};
#pragma unroll 4
            for (int kk = 0; kk < 16; ++kk) { const int k = w * 16 + kk; const float4 s = *(const float4*)(S0 + (size_t)k * 256 + 4 * lane); const float a = af[k], ks = ksf[k], q = qf[k];
                float4 sn; sn.x = fmaf(a, s.x, ks * v4.x); sn.y = fmaf(a, s.y, ks * v4.y); sn.z = fmaf(a, s.z, ks * v4.z); sn.w = fmaf(a, s.w, ks * v4.w);
                *(float4*)(S1 + (size_t)k * 256 + 4 * lane) = sn;
                op.x = fmaf(q, s.x, op.x); op.y = fmaf(q, s.y, op.y); op.z = fmaf(q, s.z, op.z); op.w = fmaf(q, s.w, op.w); }
            *(float4*)(OP + w * 256 + 4 * lane) = op;
            __syncthreads();
            float ov = 0.f;
            if (tid < 256) { float qk = 0.f;
                for (int k = 0; k < 128; ++k) qk = fmaf(qf[k], kif[k], qk);
                ov = qk * vf[tid];
#pragma unroll
                for (int ww = 0; ww < 8; ++ww) ov += OP[ww * 256 + tid];
                const float ss = wave_sum(ov * ov); if (lane == 0) red[w] = ss; }
            __syncthreads();
            if (tid < 256) { const float rstd = rsqrtf((red[0] + red[1] + red[2] + red[3]) * (1.0f / 256.0f) + EPS);
                const float g = bf2f(Z[(size_t)r * NZ + ZG + h * 256 + tid]);
                wsb(p, OFF_OG)[(size_t)r * 1024 + h * 256 + tid] = f2bf(ov * rstd * p.gng[l * 256 + tid] * siluf_(g)); }
        } else {
            const int ch = it - 512, cgp = tid & 63; const bool prompt = ch < 256;
            float w0[8], w1[8], w2[8];
#pragma unroll
            for (int e = 0; e < 8; ++e) { w0[e] = p.conv_w[(l * 3 + 0) * 512 + cgp * 8 + e]; w1[e] = p.conv_w[(l * 3 + 1) * 512 + cgp * 8 + e]; w2[e] = p.conv_w[(l * 3 + 2) * 512 + cgp * 8 + e]; }
            for (int e8 = 0; e8 < 8; ++e8) { const int j = (tid >> 6) + 8 * e8, r = ch * 64 + j; const bf16_t* zr = Z + (size_t)r * NZ;
                float z0[8], z1[8], z2[8];
                { const u32x4 a = *(const u32x4*)(zr + ZCC + cgp * 8), bq = *(const u32x4*)(zr + ZCH + cgp * 8);
                  z0[0] = bflo(a.x) * bflo(bq.x); z0[1] = bfhi(a.x) * bfhi(bq.x); z0[2] = bflo(a.y) * bflo(bq.y); z0[3] = bfhi(a.y) * bfhi(bq.y);
                  z0[4] = bflo(a.z) * bflo(bq.z); z0[5] = bfhi(a.z) * bfhi(bq.z); z0[6] = bflo(a.w) * bflo(bq.w); z0[7] = bfhi(a.w) * bfhi(bq.w); }
                if (prompt) { const int t = r & (SEQ - 1);
#pragma unroll
                    for (int e = 0; e < 8; ++e) { z1[e] = 0.f; z2[e] = 0.f; }
                    if (t >= 1) { const u32x4 a = *(const u32x4*)(zr - NZ + ZCC + cgp * 8), bq = *(const u32x4*)(zr - NZ + ZCH + cgp * 8);
                        z1[0] = bflo(a.x) * bflo(bq.x); z1[1] = bfhi(a.x) * bfhi(bq.x); z1[2] = bflo(a.y) * bflo(bq.y); z1[3] = bfhi(a.y) * bfhi(bq.y);
                        z1[4] = bflo(a.z) * bflo(bq.z); z1[5] = bfhi(a.z) * bfhi(bq.z); z1[6] = bflo(a.w) * bflo(bq.w); z1[7] = bfhi(a.w) * bfhi(bq.w); }
                    if (t >= 2) { const u32x4 a = *(const u32x4*)(zr - 2 * NZ + ZCC + cgp * 8), bq = *(const u32x4*)(zr - 2 * NZ + ZCH + cgp * 8);
                        z2[0] = bflo(a.x) * bflo(bq.x); z2[1] = bfhi(a.x) * bfhi(bq.x); z2[2] = bflo(a.y) * bflo(bq.y); z2[3] = bfhi(a.y) * bfhi(bq.y);
                        z2[4] = bflo(a.z) * bflo(bq.z); z2[5] = bfhi(a.z) * bfhi(bq.z); z2[6] = bflo(a.w) * bflo(bq.w); z2[7] = bfhi(a.w) * bfhi(bq.w); }
                    if (t >= SEQ - 2) { float* dst = p.out + OUT_CP + (((size_t)l * NBATCH + (r >> 11)) * 2 + (t - (SEQ - 2))) * 512 + cgp * 8;
                        *(float4*)dst = (float4){z0[0], z0[1], z0[2], z0[3]}; *(float4*)(dst + 4) = (float4){z0[4], z0[5], z0[6], z0[7]}; }
                } else { const int sr = r - TP; const float* b0 = p.sconv + (((size_t)l * SB + sr) * 2 + 0) * 512 + cgp * 8; const float* b1 = b0 + 512;
                    const float4 a0 = *(const float4*)b0, a1 = *(const float4*)(b0 + 4), c0 = *(const float4*)b1, c1 = *(const float4*)(b1 + 4);
                    z2[0] = a0.x; z2[1] = a0.y; z2[2] = a0.z; z2[3] = a0.w; z2[4] = a1.x; z2[5] = a1.y; z2[6] = a1.z; z2[7] = a1.w;
                    z1[0] = c0.x; z1[1] = c0.y; z1[2] = c0.z; z1[3] = c0.w; z1[4] = c1.x; z1[5] = c1.y; z1[6] = c1.z; z1[7] = c1.w;
                    float* dst = p.out + OUT_CS + (((size_t)l * SB + sr) * 2) * 512 + cgp * 8;
                    *(float4*)dst = c0; *(float4*)(dst + 4) = c1;
                    *(float4*)(dst + 512) = (float4){z0[0], z0[1], z0[2], z0[3]}; *(float4*)(dst + 516) = (float4){z0[4], z0[5], z0[6], z0[7]}; }
                const u32x4 cb = *(const u32x4*)(zr + ZCB + cgp * 8), gc = *(const u32x4*)(zr + ZGC + cgp * 8);
                float y[8];
#pragma unroll
                for (int e = 0; e < 8; ++e) y[e] = w0[e] * z2[e] + w1[e] * z1[e] + w2[e] * z0[e];
                u32x4 o; o.x = cvt_pk_bf16(bflo(cb.x) * y[0] * siluf_(bflo(gc.x)), bfhi(cb.x) * y[1] * siluf_(bfhi(gc.x))); o.y = cvt_pk_bf16(bflo(cb.y) * y[2] * siluf_(bflo(gc.y)), bfhi(cb.y) * y[3] * siluf_(bfhi(gc.y)));
                o.z = cvt_pk_bf16(bflo(cb.z) * y[4] * siluf_(bflo(gc.z)), bfhi(cb.z) * y[5] * siluf_(bfhi(gc.z))); o.w = cvt_pk_bf16(bflo(cb.w) * y[6] * siluf_(bflo(gc.w)), bfhi(cb.w) * y[7] * siluf_(bfhi(gc.w)));
                *(u32x4*)(wsb(p, OFF_YC) + (size_t)r * 512 + cgp * 8) = o; }
        }
    }
}
__device__ __forceinline__ void phase3(const P& p, unsigned char* sm, int l) {
    if (gridDim.x >= 64) {
#ifndef P3_SKIP_GLA
        if (blockIdx.x < 32) gla_prompt(p, sm, l, blockIdx.x >> 2, blockIdx.x & 3);
#endif
#ifndef P3_SKIP_OTHER
        if (blockIdx.x >= 32) p3_other(p, sm, l, 32, (int)gridDim.x - 32);
#endif
    } else {
        return;
    }
}

__global__ void __launch_bounds__(NTHR, 2) fwd_mega(P p) {
    extern __shared__ __attribute__((aligned(16))) unsigned char smem[];
    cg::grid_group grid = cg::this_grid();
    volatile LAS unsigned* bst = (volatile LAS unsigned*)((LAS unsigned char*)smem + LDS_BYTES - 64);
    if (threadIdx.x < 16) bst[threadIdx.x] = 0u;
    __syncthreads();
#if USE_XCD_BAR
    XcdBarrier bar; bar.bar = (unsigned*)(p.ws + OFF_CTL); bar.x = 0; bar.st = nullptr;
    if (p.ph_hi - p.ph_lo > 1) bar = xcd_barrier_post((unsigned*)(p.ws + OFF_CTL), bst);
#endif
#ifndef PH_MASK
#define PH_MASK 0xfff
#endif
#define PHON(k) ((PH_MASK >> (k)) & 1)
#if USE_XCD_BAR
#define SEAM(k) do { if ((k) + 1 < p.ph_hi) { if ((k) == p.ph_lo) grid.sync(); else xcd_barrier(bar); } } while (0)
#else
#define SEAM(k) do { if ((k) + 1 < p.ph_hi) grid.sync(); } while (0)
#endif
#define RUN(k, call) do { if (p.ph_lo <= (k) && (k) < p.ph_hi) { if (PHON(k)) { call; } SEAM(k); } } while (0)
    RUN(0, phase0(p, smem));
    RUN(1, phase1(p, smem, 0, 0));
    RUN(2, phase2(p, smem, 0));
    RUN(3, phase3(p, smem, 0));
    RUN(4, phase4(p, smem, 0));
    RUN(5, phase5(p, smem, 0));
    RUN(6, phase1(p, smem, 1, 1));
    RUN(7, phase2(p, smem, 1));
    RUN(8, phase3(p, smem, 1));
    RUN(9, phase4(p, smem, 1));
    RUN(10, phase5(p, smem, 1));
    RUN(11, phase1(p, smem, 1, 2));
}

extern "C" void kernel_launch(void* const* d_in, const int* in_sizes, int n_in, void* d_out, int out_size, void* d_ws, size_t ws_size, hipStream_t stream) {
    static int grid = 0;
    if (grid == 0) {
        if (n_in != 18 || (size_t)out_size != OUT_END || ws_size < WS_END) { fprintf(stderr, "kernel_launch: unexpected sizes: n_in %d out %d (want %zu) ws %zu (want >= %zu)\n", n_in, out_size, (size_t)OUT_END, ws_size, (size_t)WS_END); grid = -1; return; }
        int dev = 0, cus = 0, per_cu = 0;
        hipGetDevice(&dev); hipDeviceGetAttribute(&cus, hipDeviceAttributeMultiprocessorCount, dev);
        if (hipFuncSetAttribute((const void*)fwd_mega, hipFuncAttributeMaxDynamicSharedMemorySize, LDS_BYTES) != hipSuccess) { fprintf(stderr, "kernel_launch: hipFuncSetAttribute failed\n"); grid = -1; return; }
        if (hipOccupancyMaxActiveBlocksPerMultiprocessor(&per_cu, (const void*)fwd_mega, NTHR, LDS_BYTES) != hipSuccess || per_cu < 1) { fprintf(stderr, "kernel_launch: occupancy query failed (%d)\n", per_cu); per_cu = 1; (void)hipGetLastError(); }
        grid = cus;
    }
    if (grid < 0) return;
    hipMemsetAsync((char*)d_ws + OFF_CTL, 0, SZ_CTL, stream);
    P p{};
    p.xp = (const float*)d_in[0]; p.xs = (const float*)d_in[1]; p.cp = (const float*)d_in[2]; p.cs = (const float*)d_in[3]; p.sgla = (const float*)d_in[4]; p.sconv = (const float*)d_in[5];
    p.w_ada = (const float*)d_in[6]; p.b_ada = (const float*)d_in[7]; p.w_in = (const float*)d_in[8]; p.w_a2 = (const float*)d_in[9]; p.b_a = (const float*)d_in[10]; p.gng = (const float*)d_in[11];
    p.conv_w = (const float*)d_in[12]; p.w_pa = (const float*)d_in[13]; p.w_pb = (const float*)d_in[14]; p.w_o = (const float*)d_in[15]; p.ln_g = (const float*)d_in[16]; p.ln_b = (const float*)d_in[17];
    p.out = (float*)d_out; p.ws = (unsigned char*)d_ws;
#if N_LAUNCH_PER_PHASE
    for (int ph = 0; ph < 12; ++ph) { p.ph_lo = ph; p.ph_hi = ph + 1; hipLaunchKernelGGL(fwd_mega, dim3(grid), dim3(NTHR), LDS_BYTES, stream, p); }
#else
    p.ph_lo = 0; p.ph_hi = 12;
    void* args[] = {&p};
    hipError_t e = hipLaunchCooperativeKernel((const void*)fwd_mega, dim3(grid), dim3(NTHR), args, LDS_BYTES, stream);
    if (e != hipSuccess) fprintf(stderr, "kernel_launch: cooperative launch failed: %s (grid %d)\n", hipGetErrorString(e), grid);
#endif
}
```

```cpp
#include <hip/hip_runtime.h>
#include <hip/hip_cooperative_groups.h>
#include <cstdio>
#include <cstdint>
namespace cg = cooperative_groups;
#ifndef USE_XCD_BAR
#define USE_XCD_BAR 1
#endif
#ifndef N_LAUNCH_PER_PHASE
#define N_LAUNCH_PER_PHASE 0
#endif
#define LAS __attribute__((address_space(3)))
__device__ __forceinline__ int opaque_zero() { int z; asm volatile("s_mov_b32 %0, 0" : "=s"(z)); return z; }
namespace pg8 {
#define PG8_LAS __attribute__((address_space(3)))
typedef unsigned short bf16_t;
typedef short bf16x8 __attribute__((ext_vector_type(8)));
typedef float f32x4 __attribute__((ext_vector_type(4)));
typedef unsigned u32x4 __attribute__((ext_vector_type(4)));
constexpr int BM = 256, BK = 64, HALF = 128, HTB = HALF * BK * 2  , STAGE_BYTES = 8 * HTB, NXCD = 8, WGM = 2;

__host__ __device__ __forceinline__ int lds_byte(int r, int c) { const int st = (r >> 4) * 2 + (c >> 5), rr = r & 15, cc = c & 31, ob = rr * 64 + cc * 2; return st * 1024 + (ob ^ (((ob >> 9) & 1) << 5)); }
__host__ __device__ __forceinline__ void stage_rc(int b, int& R, int& C) { const int st = b / 1024, sb = b % 1024, swz = sb ^ (((sb >> 9) & 1) << 5); R = (st >> 1) * 16 + swz / 64; C = (st & 1) * 32 + (swz % 64) / 2; }
__host__ __device__ __forceinline__ int perm32(int rho) { const int n = rho >> 4, i = rho & 15; return 8 * (i >> 2) + 4 * n + (i & 3); }
struct Unit { int pm, pn; };
struct Gemm { const bf16_t* A; const bf16_t* Bt; int M, N, K; };

struct StaticOrder {
    int nM, nN, nwg, G, c;
    __host__ __device__ void init(int M, int N, int G_, int c_) { nM = M / BM; nN = N / BM; nwg = nM * nN; G = G_; c = c_; }
    __host__ __device__ bool next(int i, Unit& u) const {
        const long L = (long)i * G + c; if (L >= nwg) return false;
        int wgid = (int)L; { const int q = nwg / NXCD, r = nwg % NXCD, xcd = wgid % NXCD, off = wgid / NXCD; wgid = (xcd < r ? xcd * (q + 1) : r * (q + 1) + (xcd - r) * q) + off; }
        const int nig = WGM * nN, gid = wgid / nig, fm = gid * WGM, gsz = (nM - fm) < WGM ? (nM - fm) : WGM;
        u.pm = fm + ((wgid % nig) % gsz); u.pn = (wgid % nig) / gsz; return true;
    }
    __device__ __forceinline__ void a_ready(const Unit&) const {}
    __device__ __forceinline__ void done(const Unit&) const {}
};
typedef __bf16 bf16x2n __attribute__((ext_vector_type(2)));
typedef float f32x2n __attribute__((ext_vector_type(2)));
__device__ __forceinline__ unsigned cvt_pk_bf16(float lo, float hi) { f32x2n v = {lo, hi}; bf16x2n b = __builtin_convertvector(v, bf16x2n); return __builtin_bit_cast(unsigned, b); }
template <class Epi, class Sched, bool STAMP = false>
__device__ __forceinline__ void gemm_phase(PG8_LAS unsigned char* lds, const Gemm g, const Sched& S, const Epi& E, unsigned long long* stamps) {
    const int tid = threadIdx.x + opaque_zero(), wid = __builtin_amdgcn_readfirstlane(tid >> 6), lane = tid & 63, wr = wid >> 2, wc = wid & 3, fr = lane & 15, fq = lane >> 4;
    const int K = g.K, nt = K / BK;
    int ts_lo = 0, ts_hi = 0, nts = 0; const unsigned long long rt_entry = STAMP ? (unsigned long long)wall_clock64() : 0ull;
#define PG8_STAMP() do { if (STAMP && wid == 0 && nts < 64) { const unsigned long long _c = (unsigned long long)clock64(); \
        ts_lo = (lane == nts) ? (int)(unsigned)_c : ts_lo; ts_hi = (lane == nts) ? (int)(unsigned)(_c >> 32) : ts_hi; ++nts; } } while (0)
    PG8_STAMP();
    unsigned voffA[2], voffB[2];
#pragma unroll
    for (int i = 0; i < 2; ++i) { int R, C; stage_rc(tid * 16 + i * 8192, R, C); const int Rb = Epi::PERM ? ((R & ~31) + perm32(R & 31)) : R;
        voffA[i] = (unsigned)(R * K + C) * 2u; voffB[i] = (unsigned)(Rb * K + C) * 2u; }
    const size_t kstep = (size_t)(BK * 2);
    const size_t hstep = (size_t)HALF * K * 2;
    const size_t tstep = 2 * hstep;
    const unsigned ldsw = (unsigned)wid * 1024u;
    const int aoff = lds_byte(wr * 64 + fr, fq * 8), boff = lds_byte(wc * 32 + fr, fq * 8);
#define PG8_SA(b, h) (((b) * 2 + (h)) * HTB)
#define PG8_SB(b, h) ((4 + (b) * 2 + (h)) * HTB)
#define PG8_STAGE(bufoff, gbase, voff) do { _Pragma("unroll") for (int _i = 0; _i < 2; ++_i) \
        __builtin_amdgcn_global_load_lds((const unsigned*)((const char*)(gbase) + (voff)[_i]), (PG8_LAS unsigned*)(lds + (bufoff) + ldsw + _i * 8192), 16, 0, 0); } while (0)
#define PG8_LDA(dst, b, h) do { _Pragma("unroll") for (int m = 0; m < 4; ++m) _Pragma("unroll") for (int k = 0; k < 2; ++k) dst[m][k] = *(const PG8_LAS bf16x8*)(lds + PG8_SA(b, h) + aoff + m * 2048 + k * 1024); } while (0)
#define PG8_LDB(dst, b, h) do { _Pragma("unroll") for (int n = 0; n < 2; ++n) _Pragma("unroll") for (int k = 0; k < 2; ++k) dst[n][k] = *(const PG8_LAS bf16x8*)(lds + PG8_SB(b, h) + boff + n * 2048 + k * 1024); } while (0)
#define PG8_MMA(ai, bj, At, Bt) do { __builtin_amdgcn_s_setprio(1); _Pragma("unroll") for (int m = 0; m < 4; ++m) _Pragma("unroll") for (int n = 0; n < 2; ++n) _Pragma("unroll") for (int k = 0; k < 2; ++k) \
        acc[ai][bj][m][n] = __builtin_amdgcn_mfma_f32_16x16x32_bf16(Bt[n][k], At[m][k], acc[ai][bj][m][n], 0, 0, 0); __builtin_amdgcn_s_setprio(0); } while (0)
#define PG8_WAIT_V(n) asm volatile("s_waitcnt vmcnt(" #n ")" ::: "memory")
#define PG8_WAIT_L(n) asm volatile("s_waitcnt lgkmcnt(" #n ")" ::: "memory")
#define PG8_BAR __builtin_amdgcn_s_barrier()
#define PG8_SCHED __builtin_amdgcn_sched_barrier(0)
    Unit cur, nxt; int ui = 0;
    if (!S.next(0, cur)) return;
    f32x4 acc[2][2][4][2];
#pragma unroll
    for (int a = 0; a < 2; ++a)
#pragma unroll
        for (int b = 0; b < 2; ++b)
#pragma unroll
            for (int m = 0; m < 4; ++m)
#pragma unroll
                for (int n = 0; n < 2; ++n) acc[a][b][m][n] = (f32x4){0.f, 0.f, 0.f, 0.f};
    bf16x8 At[4][2], B0[2][2], B1[2][2];
    const char* cA = (const char*)g.A + (size_t)cur.pm * tstep; const char* cB = (const char*)g.Bt + (size_t)cur.pn * tstep;
    S.a_ready(cur);
    PG8_STAGE(PG8_SB(0, 0), cB, voffB); PG8_STAGE(PG8_SA(0, 0), cA, voffA); PG8_STAGE(PG8_SB(0, 1), cB + hstep, voffB); PG8_STAGE(PG8_SA(0, 1), cA + hstep, voffA);
    if (wr == 1) PG8_BAR;
    PG8_WAIT_V(4); PG8_BAR;
    PG8_STAGE(PG8_SB(1, 0), cB + kstep, voffB); PG8_STAGE(PG8_SA(1, 0), cA + kstep, voffA); PG8_STAGE(PG8_SB(1, 1), cB + hstep + kstep, voffB);
    PG8_WAIT_V(6); PG8_BAR;
    PG8_STAMP();
    for (;;) {
        const bool has_next = S.next(ui + 1, nxt);
        const char* nA = has_next ? (const char*)g.A + (size_t)nxt.pm * tstep : cA; const char* nB = has_next ? (const char*)g.Bt + (size_t)nxt.pn * tstep : cB;
        for (int t = 0; t < nt; t += 2) {
            const bool last = (t == nt - 2);
            const char* a1 = cA + (size_t)(t + 1) * kstep;
            const char* a2 = last ? nA : cA + (size_t)(t + 2) * kstep; const char* b2 = last ? nB : cB + (size_t)(t + 2) * kstep;
            const char* a3 = a2 + kstep; const char* b3 = b2 + kstep;
            if (last && has_next) S.a_ready(nxt);
            PG8_LDB(B0, 0, 0); PG8_SCHED; PG8_LDA(At, 0, 0); PG8_STAGE(PG8_SA(1, 1), a1 + hstep, voffA);
            PG8_WAIT_L(8); PG8_BAR; PG8_WAIT_L(0); PG8_MMA(0, 0, At, B0); PG8_BAR; PG8_SCHED;
            PG8_LDB(B1, 0, 1); PG8_STAGE(PG8_SB(0, 0), b2, voffB);
            PG8_BAR; PG8_WAIT_L(0); PG8_MMA(0, 1, At, B1); PG8_BAR;
            PG8_LDA(At, 0, 1); PG8_STAGE(PG8_SA(0, 0), a2, voffA);
            PG8_BAR; PG8_WAIT_L(0); PG8_MMA(1, 0, At, B0); PG8_BAR; PG8_SCHED;
            PG8_STAGE(PG8_SB(0, 1), b2 + hstep, voffB);
            PG8_WAIT_V(6); PG8_BAR; PG8_MMA(1, 1, At, B1); PG8_BAR;
            PG8_LDB(B0, 1, 0); PG8_SCHED; PG8_LDA(At, 1, 0); PG8_STAGE(PG8_SA(0, 1), a2 + hstep, voffA);
            PG8_WAIT_L(8); PG8_BAR; PG8_WAIT_L(0); PG8_MMA(0, 0, At, B0); PG8_BAR; PG8_SCHED;
            PG8_LDB(B1, 1, 1); PG8_STAGE(PG8_SB(1, 0), b3, voffB);
            PG8_BAR; PG8_WAIT_L(0); PG8_MMA(0, 1, At, B1); PG8_BAR;
            PG8_LDA(At, 1, 1); PG8_STAGE(PG8_SA(1, 0), a3, voffA);
            PG8_BAR; PG8_WAIT_L(0); PG8_MMA(1, 0, At, B0); PG8_BAR; PG8_SCHED;
            PG8_STAGE(PG8_SB(1, 1), b3 + hstep, voffB);
            PG8_WAIT_V(6); PG8_BAR; PG8_MMA(1, 1, At, B1); PG8_BAR;
        }
        PG8_STAMP();
        if constexpr (!Epi::AFTER_DRAIN) { E(acc, cur, wr, wc, fr, fq); S.done(cur); }
        PG8_STAMP();
        if (!has_next) break;
#pragma unroll
        for (int a = 0; a < 2; ++a)
#pragma unroll
            for (int b = 0; b < 2; ++b)
#pragma unroll
                for (int m = 0; m < 4; ++m)
#pragma unroll
                    for (int n = 0; n < 2; ++n) acc[a][b][m][n] = (f32x4){0.f, 0.f, 0.f, 0.f};
        cur = nxt; cA = nA; cB = nB; ++ui;
    }
    PG8_WAIT_V(0);
    if (wr == 0) PG8_BAR;
    PG8_BAR;
    if constexpr (Epi::AFTER_DRAIN) { E.fused(acc, cur, wr, wc, fr, fq, lds, wid, lane); S.done(cur); }
    PG8_STAMP();
    if (STAMP && wid == 0) { stamps[lane] = lane < nts ? (((unsigned long long)(unsigned)ts_hi << 32) | (unsigned)ts_lo) : 0ull;
        if (lane == 62) stamps[62] = rt_entry; if (lane == 63) stamps[63] = (unsigned long long)wall_clock64(); }
#undef PG8_STAMP
#undef PG8_SA
#undef PG8_SB
#undef PG8_STAGE
#undef PG8_LDA
#undef PG8_LDB
#undef PG8_MMA
#undef PG8_WAIT_V
#undef PG8_WAIT_L
#undef PG8_BAR
#undef PG8_SCHED
}
}
#define XB_TMO      128
#define XB_XCNT(j)  (256  + 64 * (j))
#define XB_XSUB(j)  (1280 + 64 * (j))
#define XB_XGEN(j)  (2304 + 64 * (j))
#define XB_TOP      3328
#define XB_TOPGEN   3392
#define XCD_BAR_WORDS 3456
#define XB_SPIN_CAP (1u << 18)

__device__ __forceinline__ unsigned xb_ld(unsigned* p)              { return __hip_atomic_load(p, __ATOMIC_RELAXED, __HIP_MEMORY_SCOPE_AGENT); }
__device__ __forceinline__ unsigned xb_add(unsigned* p, unsigned v) { return __hip_atomic_fetch_add(p, v, __ATOMIC_RELAXED, __HIP_MEMORY_SCOPE_AGENT); }
__device__ __forceinline__ unsigned xb_xcc_id() { return (unsigned)__builtin_amdgcn_s_getreg((3 << 11) | 20) & 0xFu; }
#define XB_SPIN(cond, bar) do { unsigned _sp = 0; while (cond) { __builtin_amdgcn_s_sleep(1); \
    if ((++_sp & 255u) == 0u) { if (xb_ld(&(bar)[XB_TMO])) break; if (_sp > XB_SPIN_CAP) { atomicAdd(&(bar)[XB_TMO], 1u); break; } } } } while (0)

struct XcdBarrier {
    unsigned* bar; unsigned x;
    volatile LAS unsigned* st;
};

__device__ __forceinline__ XcdBarrier xcd_barrier_post(unsigned* bar, volatile LAS unsigned* st) {
    XcdBarrier b; b.bar = bar; b.x = xb_xcc_id(); b.st = st;
    if (threadIdx.x == 0) (void)xb_add(&bar[XB_XCNT(b.x)], 1u);
    return b;
}
__device__ __forceinline__ void xcd_barrier_complete(unsigned* bar, unsigned x, unsigned& nloc, unsigned& nx) {
    const unsigned G = gridDim.x * gridDim.y * gridDim.z;
    unsigned sum, cnt, mine, sp = 0u;
    for (;;) {
        sum = 0u; cnt = 0u; mine = 0u;
#pragma unroll
        for (unsigned j = 0; j < 16; ++j) { const unsigned c = xb_ld(&bar[XB_XCNT(j)]); sum += c; cnt += (c > 0u) ? 1u : 0u; mine = (j == x) ? c : mine; }
        if (sum == G) break;
        __builtin_amdgcn_s_sleep(1);
        if ((++sp & 255u) == 0u) { if (xb_ld(&bar[XB_TMO])) break; if (sp > XB_SPIN_CAP) { atomicAdd(&bar[XB_TMO], 1u); break; } }
    }
    nloc = mine > 0u ? mine : 1u; nx = cnt > 0u ? cnt : 1u;
}

__device__ __forceinline__ void xcd_barrier(const XcdBarrier& b) {
    asm volatile("s_waitcnt vmcnt(0)" ::: "memory");
    __syncthreads();
    if (threadIdx.x == 0) {
        unsigned* bar = b.bar;
        __builtin_amdgcn_s_waitcnt(0);
        unsigned nloc = b.st[0], nx = b.st[1];
        if (nloc == 0u) { xcd_barrier_complete(bar, b.x, nloc, nx); b.st[0] = nloc; b.st[1] = nx; }
        const unsigned old = xb_add(&bar[XB_XSUB(b.x)], 1u);
        const unsigned gen = old / nloc;
        if (old + 1u == (gen + 1u) * nloc) {
            __builtin_amdgcn_fence(__ATOMIC_RELEASE, "agent");
            asm volatile("s_waitcnt vmcnt(0)" ::: "memory");
            const unsigned og = xb_add(&bar[XB_TOP], 1u);
            const unsigned tg = og / nx;
            if (og + 1u == (tg + 1u) * nx) xb_add(&bar[XB_TOPGEN], 1u);
            else XB_SPIN(xb_ld(&bar[XB_TOPGEN]) == tg, bar);
            __builtin_amdgcn_fence(__ATOMIC_ACQUIRE, "agent");
            xb_add(&bar[XB_XGEN(b.x)], 1u);
            asm volatile("s_waitcnt vmcnt(0)" ::: "memory");
        } else {
            XB_SPIN(xb_ld(&bar[XB_XGEN(b.x)]) == gen, bar);
            __builtin_amdgcn_fence(__ATOMIC_ACQUIRE, "agent");
            asm volatile("s_waitcnt vmcnt(0)" ::: "memory");
        }
    }
    __syncthreads();
}


using pg8::bf16_t; using pg8::bf16x8; using pg8::f32x4; using pg8::u32x4; using pg8::cvt_pk_bf16;
typedef short bf16x4 __attribute__((ext_vector_type(4)));
typedef unsigned u32x2 __attribute__((ext_vector_type(2)));
constexpr int DM = 1024, TP = 16384, SB = 128, MT = TP + SB, SEQ = 2048, NBATCH = 8, NW = 7168, NZ = 4096, NIN = 7184, NADA = 136;
constexpr int ZQ = 0, ZK = 512, ZV = 1024, ZG = 0, ZZ = 1024, ZCG = 1536, ZMG = 2048, ZMC = 3072, ZSW = 4096;
constexpr float QSCALE = 0.08838834764831845f, ALPHA = 1.4142135623730951f, EPS = 1e-5f;
constexpr int NTHR = 512, LDS_BYTES = 147456;
constexpr size_t SZ_WIN = (size_t)NW * 1024 * 2, SZ_WPA = 1024 * 1024 * 2, SZ_WPB = 1024 * 512 * 2, SZ_WO = 1024 * 1024 * 2;
constexpr size_t OFF_CTL = 0, SZ_CTL = 65536;
constexpr size_t OFF_WIN = OFF_CTL + SZ_CTL, OFF_WPA = OFF_WIN + 2 * SZ_WIN, OFF_WPB = OFF_WPA + 2 * SZ_WPA, OFF_WO = OFF_WPB + 2 * SZ_WPB;
constexpr size_t OFF_ADA = OFF_WO + 2 * SZ_WO, SZ_ADA = (size_t)2 * NADA * 3072 * 4;
constexpr size_t OFF_U = OFF_ADA + SZ_ADA, SZ_U = (size_t)MT * 1024 * 2;
constexpr size_t OFF_Z = OFF_U + SZ_U, SZ_Z = (size_t)MT * NZ * 2;
constexpr size_t OFF_KST = OFF_Z + SZ_Z, SZ_KST = (size_t)MT * 512 * 2;
constexpr size_t OFF_B = OFF_KST + SZ_KST, SZ_B = (size_t)MT * 512 * 4;
constexpr size_t OFF_OG = OFF_B + SZ_B, SZ_OG = (size_t)MT * 1024 * 2;
constexpr size_t OFF_YC = OFF_OG + SZ_OG, SZ_YC = (size_t)MT * 512 * 2;
constexpr size_t OFF_Y1 = OFF_YC + SZ_YC, SZ_Y1 = (size_t)MT * 1024 * 4;
constexpr size_t OFF_VT = OFF_Y1 + SZ_Y1, SZ_VT = (size_t)TP * 1024 * 2;
constexpr size_t OFF_QF = OFF_VT + SZ_VT, SZ_QF = (size_t)TP * 512 * 2;
constexpr size_t OFF_KF = OFF_QF + SZ_QF, OFF_ZS = OFF_KF + SZ_QF, SZ_ZS = (size_t)SB * ZSW * 2;
constexpr size_t WS_END = OFF_ZS + SZ_ZS;
constexpr size_t OUT_Y = 0, OUT_GP = (size_t)MT * 1024, OUT_CP = OUT_GP + (size_t)2 * 8 * 4 * 128 * 256, OUT_GS = OUT_CP + 2 * 8 * 2 * 512, OUT_CS = OUT_GS + (size_t)2 * 128 * 4 * 128 * 256, OUT_END = OUT_CS + 2 * 128 * 2 * 512;

struct P {
    const float *xp, *xs, *cp, *cs, *sgla, *sconv, *w_ada, *b_ada, *w_in, *w_a2, *b_a, *gng, *conv_w, *w_pa, *w_pb, *w_o, *ln_g, *ln_b;
    float* out; unsigned char* ws; int ph_lo, ph_hi;
};
#define DI __device__ __forceinline__
DI bf16_t* wsb(const P& p, size_t off) { return (bf16_t*)(p.ws + off); }
DI float* wsf(const P& p, size_t off) { return (float*)(p.ws + off); }
DI float bf2f(unsigned short b) { return __uint_as_float(((unsigned)b) << 16); }
DI float bflo(unsigned w) { return __uint_as_float(w << 16); }
DI float bfhi(unsigned w) { return __uint_as_float(w & 0xffff0000u); }
DI unsigned short f2bf(float f) { return (unsigned short)(cvt_pk_bf16(f, 0.f) & 0xffffu); }
DI float sigmoidf_(float x) { return __builtin_amdgcn_rcpf(1.0f + __expf(-x)); }
DI float siluf_(float x) { return x * sigmoidf_(x); }
DI const float* xrow(const P& p, int l, int r) { return l == 0 ? (r < TP ? p.xp + (size_t)r * 1024 : p.xs + (size_t)(r - TP) * 1024) : wsf(p, OFF_Y1) + (size_t)r * 1024; }
DI int ada_row(int r) { return r < TP ? (r >> 11) : NBATCH + (r - TP); }
DI f32x4 mfma16(bf16x8 a, bf16x8 b, f32x4 c) { return __builtin_amdgcn_mfma_f32_16x16x32_bf16(a, b, c, 0, 0, 0); }
DI float wave_sum(float v) {
#pragma unroll
    for (int o = 32; o >= 1; o >>= 1) v += __shfl_xor(v, o);
    return v;
}

struct P0Tile { const float* src; bf16_t* dst; int ld, ldd; };
DI P0Tile p0_tile(const P& p, int t) {
    P0Tile r; const int l = t / 2432; int u = t % 2432;
    if (u < 1792) { const int kt = u / 112, n0 = (u % 112) * 64; int sc = n0 < 3072 ? n0 : n0 + 16;
        if (n0 < 1024) { const int hd = n0 >> 8, o = n0 & 255; sc = (o >> 7) * 512 + hd * 128 + (o & 127); }
        if (n0 >= 3072 && n0 < 5120) { const int T = n0 >> 8, o = n0 & 255, hf = o >> 7, oo = o & 127, i = (T - 12) & 3, comp = T < 16 ? (hf ? 2 : 1) : (hf ? 3 : 0);
            sc = 3088 + comp * 512 + 128 * i + oo; }
        r.src = p.w_in + (size_t)l * 1024 * NIN + (size_t)(kt * 64) * NIN + sc; r.ld = NIN; r.dst = wsb(p, OFF_WIN + l * SZ_WIN) + (size_t)n0 * 1024 + kt * 64; r.ldd = 1024; }
    else if (u < 2048) { u -= 1792; const int kt = u >> 4, n0 = (u & 15) * 64;
        r.src = p.w_pa + (size_t)l * 1024 * 1024 + (size_t)(kt * 64) * 1024 + n0; r.ld = 1024; r.dst = wsb(p, OFF_WPA + l * SZ_WPA) + (size_t)n0 * 1024 + kt * 64; r.ldd = 1024; }
    else if (u < 2176) { u -= 2048; const int kt = u >> 4, n0 = (u & 15) * 64;
        r.src = p.w_pb + (size_t)l * 512 * 1024 + (size_t)(kt * 64) * 1024 + n0; r.ld = 1024; r.dst = wsb(p, OFF_WPB + l * SZ_WPB) + (size_t)n0 * 512 + kt * 64; r.ldd = 512; }
    else { u -= 2176; const int kt = u >> 4, n0 = (u & 15) * 64;
        r.src = p.w_o + (size_t)l * 1024 * 1024 + (size_t)(kt * 64) * 1024 + n0; r.ld = 1024; r.dst = wsb(p, OFF_WO + l * SZ_WO) + (size_t)n0 * 1024 + kt * 64; r.ldd = 1024; }
    return r;
}
__device__ __forceinline__ void phase0(const P& p, unsigned char* sm) {
    const int tid = threadIdx.x + opaque_zero();
    {   const int w = tid >> 6, lane = tid & 63, fr = lane & 15, fq = lane >> 4;
        for (int t = (int)blockIdx.x * 8 + w; t < 9 * 192; t += (int)gridDim.x * 8) {
            const int ct = t / 9, rt = t - ct * 9, l = ct / 96, n0 = (ct - l * 96) * 32;
            const int row = rt * 16 + fr < NADA ? rt * 16 + fr : NADA - 1;
            const float* crow = (row < NBATCH ? p.cp + (size_t)row * 1024 : p.cs + (size_t)(row - NBATCH) * 1024) + 4 * fq;
            const float* wb = p.w_ada + (size_t)l * 1024 * 3072 + (size_t)(4 * fq) * 3072 + n0 + fr;
            f32x4 a0 = {0.f, 0.f, 0.f, 0.f}, a1 = {0.f, 0.f, 0.f, 0.f};
#pragma unroll 8
            for (int k0 = 0; k0 < 1024; k0 += 16) {
                const f32x4 av = *(const f32x4*)(crow + k0);
#pragma unroll
                for (int j = 0; j < 4; ++j) { const float b0 = wb[(size_t)(k0 + j) * 3072], b1 = wb[(size_t)(k0 + j) * 3072 + 16];
                    a0 = __builtin_amdgcn_mfma_f32_16x16x4f32(av[j], b0, a0, 0, 0, 0); a1 = __builtin_amdgcn_mfma_f32_16x16x4f32(av[j], b1, a1, 0, 0, 0); }
            }
            const float bb0 = p.b_ada[l * 3072 + n0 + fr], bb1 = p.b_ada[l * 3072 + n0 + 16 + fr];
#pragma unroll
            for (int e = 0; e < 4; ++e) { const int ro = rt * 16 + 4 * fq + e; if (ro < NADA) { float* d = wsf(p, OFF_ADA) + ((size_t)l * NADA + ro) * 3072 + n0 + fr; d[0] = a0[e] + bb0; d[16] = a1[e] + bb1; } }
        }
    }
}
__device__ __forceinline__ void p0_convert(const P& p, unsigned char* sm) {
    const int tid = threadIdx.x + opaque_zero();
    __syncthreads();
    {   float* Ts = (float*)sm;
        const int nb = (int)gridDim.x, vb = (int)blockIdx.x;
        for (int t0 = vb; t0 < 2 * 2432; t0 += 4 * nb) {
            float4 rv0[4], rv1[4]; bf16_t* tdst[4]; int tldd[4];
            const int kk = tid >> 4, n4 = (tid & 15) * 4;
#pragma unroll
            for (int q = 0; q < 4; ++q) { const int t = t0 + q * nb; const P0Tile tl = p0_tile(p, t < 2 * 2432 ? t : 2 * 2432 - 1); tdst[q] = tl.dst; tldd[q] = tl.ldd;
                rv0[q] = *(const float4*)(tl.src + (size_t)kk * tl.ld + n4); rv1[q] = *(const float4*)(tl.src + (size_t)(kk + 32) * tl.ld + n4); }
#pragma unroll
            for (int q = 0; q < 4; ++q) { float* T = Ts + q * 4160;
                { const float4 v = rv0[q]; T[kk * 65 + n4] = v.x; T[kk * 65 + n4 + 1] = v.y; T[kk * 65 + n4 + 2] = v.z; T[kk * 65 + n4 + 3] = v.w; }
                { const float4 v = rv1[q]; T[(kk + 32) * 65 + n4] = v.x; T[(kk + 32) * 65 + n4 + 1] = v.y; T[(kk + 32) * 65 + n4 + 2] = v.z; T[(kk + 32) * 65 + n4 + 3] = v.w; } }
            __syncthreads();
#pragma unroll
            for (int q = 0; q < 4; ++q) { const int t = t0 + q * nb; const float* T = Ts + q * 4160; const int n = tid >> 3, k8 = (tid & 7) * 8; u32x4 w;
                w.x = cvt_pk_bf16(T[(k8 + 0) * 65 + n], T[(k8 + 1) * 65 + n]); w.y = cvt_pk_bf16(T[(k8 + 2) * 65 + n], T[(k8 + 3) * 65 + n]);
                w.z = cvt_pk_bf16(T[(k8 + 4) * 65 + n], T[(k8 + 5) * 65 + n]); w.w = cvt_pk_bf16(T[(k8 + 6) * 65 + n], T[(k8 + 7) * 65 + n]);
                if (t < 2 * 2432) *(u32x4*)(tdst[q] + (size_t)n * tldd[q] + k8) = w; }
            __syncthreads();
        }
    }
}

DI void p1_row(const P& p, int mode, int r, float4 (&xv)[4], const float4 (&sh)[4], const float4 (&sc)[4], const float* lg_p, const float* lb_p, float* ydst, const float* WaT, float* alr, int lane) {
    if (mode != 0) {
        const float* lnp = (const float*)lg_p + opaque_zero();
        float4 lg[4], lb[4];
#pragma unroll
        for (int q = 0; q < 4; ++q) { lg[q] = *(const float4*)(lnp + 256 * q + 4 * lane); lb[q] = *(const float4*)(lnp + (lb_p - lg_p) + 256 * q + 4 * lane); }
        float s = 0.f;
#pragma unroll
        for (int q = 0; q < 4; ++q) s += xv[q].x + xv[q].y + xv[q].z + xv[q].w;
        const float mean = wave_sum(s) * (1.0f / 1024.0f);
        float vs = 0.f;
#pragma unroll
        for (int q = 0; q < 4; ++q) { xv[q].x -= mean; xv[q].y -= mean; xv[q].z -= mean; xv[q].w -= mean; vs += xv[q].x * xv[q].x + xv[q].y * xv[q].y + xv[q].z * xv[q].z + xv[q].w * xv[q].w; }
        const float rstd = rsqrtf(wave_sum(vs) * (1.0f / 1024.0f) + EPS);
#pragma unroll
        for (int q = 0; q < 4; ++q) {
            xv[q].x = xv[q].x * rstd * lg[q].x + lb[q].x; xv[q].y = xv[q].y * rstd * lg[q].y + lb[q].y; xv[q].z = xv[q].z * rstd * lg[q].z + lb[q].z; xv[q].w = xv[q].w * rstd * lg[q].w + lb[q].w;
            if (mode == 1) { u32x2 pk; pk.x = cvt_pk_bf16(xv[q].x, xv[q].y); pk.y = cvt_pk_bf16(xv[q].z, xv[q].w); *(u32x2*)((bf16_t*)ydst + (size_t)r * 1024 + 256 * q + 4 * lane) = pk; }
            else *(float4*)(ydst + (size_t)r * 1024 + 256 * q + 4 * lane) = xv[q]; }
    }
    if (mode == 2) return;
    float pa[16];
#pragma unroll
    for (int j = 0; j < 16; ++j) pa[j] = 0.f;
#pragma unroll
    for (int q = 0; q < 4; ++q) { const int c = 256 * q + 4 * lane;
        float4 u; u.x = xv[q].x * (1.0f + sc[q].x) + sh[q].x; u.y = xv[q].y * (1.0f + sc[q].y) + sh[q].y; u.z = xv[q].z * (1.0f + sc[q].z) + sh[q].z; u.w = xv[q].w * (1.0f + sc[q].w) + sh[q].w;
        u32x2 pk; pk.x = cvt_pk_bf16(u.x, u.y); pk.y = cvt_pk_bf16(u.z, u.w);
        *(u32x2*)(wsb(p, OFF_U) + (size_t)r * 1024 + c) = pk;
#pragma unroll
        for (int j = 0; j < 16; ++j) { const float4 wv = *(const float4*)(WaT + j * 1024 + c); pa[j] = fmaf(u.x, wv.x, fmaf(u.y, wv.y, fmaf(u.z, wv.z, fmaf(u.w, wv.w, pa[j])))); } }
    float p8[8], p4[4], p2[2], p1;
    { const bool b = lane & 32;
#pragma unroll
      for (int j = 0; j < 8; ++j) { const float keep = b ? pa[j + 8] : pa[j], send = b ? pa[j] : pa[j + 8]; p8[j] = keep + __shfl_xor(send, 32); } }
    { const bool b = lane & 16;
#pragma unroll
      for (int j = 0; j < 4; ++j) { const float keep = b ? p8[j + 4] : p8[j], send = b ? p8[j] : p8[j + 4]; p4[j] = keep + __shfl_xor(send, 16); } }
    { const bool b = lane & 8;
#pragma unroll
      for (int j = 0; j < 2; ++j) { const float keep = b ? p4[j + 2] : p4[j], send = b ? p4[j] : p4[j + 2]; p2[j] = keep + __shfl_xor(send, 8); } }
    { const bool b = lane & 4; const float keep = b ? p2[1] : p2[0], send = b ? p2[0] : p2[1]; p1 = keep + __shfl_xor(send, 4); }
    p1 += __shfl_xor(p1, 1); p1 += __shfl_xor(p1, 2);
    if ((lane & 3) == 0) { const int r16 = 8 * ((lane >> 5) & 1) + 4 * ((lane >> 4) & 1) + 2 * ((lane >> 3) & 1) + ((lane >> 2) & 1); alr[r16] = p1; }
}
__device__ __forceinline__ void phase1(const P& p, unsigned char* sm, int l, int mode) {
    const int tid = threadIdx.x + opaque_zero(), w = tid >> 6, lane = tid & 63;
    float* WaT = (float*)sm;
    float* ALR = (float*)(sm + 65536);
    if (mode != 2) {
        const float* wsrc = p.w_in + (size_t)l * 1024 * NIN + 3072;
#pragma unroll 8
        for (int e = tid; e < 16384; e += NTHR) { const int k = e >> 4, r = e & 15; WaT[r * 1024 + k] = wsrc[(size_t)k * NIN + r]; }
    }
    const bf16_t* GO = wsb(p, OFF_Z);
    const float* xprev = (mode == 1) ? p.xp : wsf(p, OFF_Y1);
    const int lnl = (mode == 1) ? l - 1 : l;
    float* ydst = (mode == 1) ? wsf(p, OFF_Y1) : p.out + OUT_Y;
    const float* lg = p.ln_g + lnl * 1024; const float* lb = p.ln_b + lnl * 1024;
    __syncthreads();
    for (int it = blockIdx.x; it < TP / 64; it += gridDim.x) {
        const float* ada = wsf(p, OFF_ADA) + ((size_t)l * NADA + (it >> 5)) * 3072;
        float4 sh[4], sc[4];
#pragma unroll
        for (int q = 0; q < 4; ++q) { sh[q] = (float4){0.f, 0.f, 0.f, 0.f}; sc[q] = sh[q]; }
        if (mode != 2) {
#pragma unroll
            for (int q = 0; q < 4; ++q) { sh[q] = *(const float4*)(ada + 256 * q + 4 * lane); sc[q] = *(const float4*)(ada + 1024 + 256 * q + 4 * lane); } }
#pragma unroll 1
        for (int g = 0; g < 2; ++g) {
            float4 xv[4][4]; u32x2 gv[4][4];
#pragma unroll
            for (int rr = 0; rr < 4; ++rr) { const int r = it * 64 + w * 8 + g * 4 + rr; const float* src = (mode == 0) ? p.xp + (size_t)r * 1024 : xprev + (size_t)r * 1024;
#pragma unroll
                for (int q = 0; q < 4; ++q) {
                    if (mode == 2) { const u32x2 yb = *(const u32x2*)((const bf16_t*)xprev + (size_t)r * 1024 + 256 * q + 4 * lane); xv[rr][q] = (float4){bflo(yb.x), bfhi(yb.x), bflo(yb.y), bfhi(yb.y)}; }
                    else xv[rr][q] = *(const float4*)(src + 256 * q + 4 * lane);
                    if (mode != 0) gv[rr][q] = *(const u32x2*)(GO + (size_t)r * 1024 + 256 * q + 4 * lane); } }
#pragma unroll
            for (int rr = 0; rr < 4; ++rr) { const int i = w * 8 + g * 4 + rr;
                if (mode != 0) {
#pragma unroll
                    for (int q = 0; q < 4; ++q) { const u32x2 gq = gv[rr][q]; xv[rr][q].x = ALPHA * xv[rr][q].x + bflo(gq.x); xv[rr][q].y = ALPHA * xv[rr][q].y + bfhi(gq.x); xv[rr][q].z = ALPHA * xv[rr][q].z + bflo(gq.y); xv[rr][q].w = ALPHA * xv[rr][q].w + bfhi(gq.y); } }
                p1_row(p, mode, it * 64 + i, xv[rr], sh, sc, lg, lb, ydst, WaT, ALR + i * 16, lane); }
        }
        const bool has_s = it < SB;
        if (has_s && w == 0) {
            const int r = TP + it; const float* src = (mode == 2) ? xprev + (size_t)r * 1024 : p.xs + (size_t)it * 1024;
            const float* ada_s = wsf(p, OFF_ADA) + ((size_t)l * NADA + NBATCH + it) * 3072;
            float4 xs[4], sh2[4], sc2[4];
#pragma unroll
            for (int q = 0; q < 4; ++q) { sh2[q] = sh[q]; sc2[q] = sc[q];
                if (mode == 2) { const u32x2 yb = *(const u32x2*)((const bf16_t*)xprev + (size_t)r * 1024 + 256 * q + 4 * lane); xs[q] = (float4){bflo(yb.x), bfhi(yb.x), bflo(yb.y), bfhi(yb.y)}; }
                else xs[q] = *(const float4*)(src + 256 * q + 4 * lane);
                if (mode != 0) { const u32x2 gq = *(const u32x2*)(GO + (size_t)r * 1024 + 256 * q + 4 * lane);
                    xs[q].x = ALPHA * xs[q].x + bflo(gq.x); xs[q].y = ALPHA * xs[q].y + bfhi(gq.x); xs[q].z = ALPHA * xs[q].z + bflo(gq.y); xs[q].w = ALPHA * xs[q].w + bfhi(gq.y); } }
            if (mode != 2) {
#pragma unroll
                for (int q = 0; q < 4; ++q) { sh2[q] = *(const float4*)(ada_s + 256 * q + 4 * lane); sc2[q] = *(const float4*)(ada_s + 1024 + 256 * q + 4 * lane); } }
            p1_row(p, mode, r, xs, sh2, sc2, lg, lb, ydst, WaT, ALR + 64 * 16, lane);
        }
        if (mode == 2) continue;
        __syncthreads();
        {
            float w2[16];
#pragma unroll
            for (int j = 0; j < 16; ++j) w2[j] = p.w_a2[((size_t)l * 16 + j) * 512 + tid];
            const float ba = p.b_a[l * 512 + tid];
            float run = 0.f; float* Bc = wsf(p, OFF_B) + (size_t)it * 64 * 512 + tid;
#pragma unroll 4
            for (int i = 0; i < 64; ++i) {
                float x = ba;
#pragma unroll
                for (int j4 = 0; j4 < 4; ++j4) { const float4 a = *(const float4*)(ALR + i * 16 + 4 * j4); x = fmaf(a.x, w2[4 * j4], fmaf(a.y, w2[4 * j4 + 1], fmaf(a.z, w2[4 * j4 + 2], fmaf(a.w, w2[4 * j4 + 3], x)))); }
                run += (fminf(x, 0.f) - __logf(1.0f + __expf(-fabsf(x)))) * (1.0f / 16.0f);
                Bc[(size_t)i * 512] = run;
            }
            if (has_s) { float x = ba;
#pragma unroll
                for (int j4 = 0; j4 < 4; ++j4) { const float4 a = *(const float4*)(ALR + 64 * 16 + 4 * j4); x = fmaf(a.x, w2[4 * j4], fmaf(a.y, w2[4 * j4 + 1], fmaf(a.z, w2[4 * j4 + 2], fmaf(a.w, w2[4 * j4 + 3], x)))); }
                wsf(p, OFF_B)[(size_t)(TP + it) * 512 + tid] = (fminf(x, 0.f) - __logf(1.0f + __expf(-fabsf(x)))) * (1.0f / 16.0f); }
        }
        __syncthreads();
    }
}

DI void in_elem(const P& p, int r, int c, float v) {
    bf16_t* Z = wsb(p, OFF_Z); const float* Bc = wsf(p, OFF_B);
    bf16_t* ZS = wsb(p, OFF_ZS) + (size_t)(r - TP) * ZSW;
    if (c < 1024) { const int hd = c >> 8, o = c & 255, cc = hd * 128 + (o & 127); const float b = Bc[(size_t)r * 512 + cc];
        if (o < 128) ZS[ZQ + cc] = f2bf(v * QSCALE * __expf(b));
        else { ZS[ZK + cc] = f2bf(v * __expf(-b)); wsb(p, OFF_KST)[(size_t)r * 512 + cc] = f2bf(v); } }
    else if (c < 2048) ZS[c] = f2bf(v);
    else if (c < 3072) Z[(size_t)r * NZ + c - 2048] = f2bf(v);
    else if (c < 5120) { const int T = c >> 8, o = c & 255, hf = o >> 7, oo = o & 127, i = (T - 12) & 3, comp = T < 16 ? (hf ? 1 : 0) : (hf ? 3 : 2);
        ZS[2048 + comp * 512 + 128 * i + oo] = f2bf(v); }
    else Z[(size_t)r * NZ + c - 3072] = f2bf(v);
}
DI u32x4 wave_transpose_16x32(LAS unsigned char* T, int fr, int fq, const float (&v)[8]) {
    const int wo = (8 * fq * 16 + fr) * 2 + fq * 16;
#pragma unroll
    for (int e = 0; e < 8; ++e) *(LAS bf16_t*)(T + wo + e * 32) = f2bf(v[e]);
    const int lane = fq * 16 + fr, col = lane >> 1, half = lane & 1;
    return *(const LAS u32x4*)(T + (col * 16 + half * 8) * 2 + (col >> 3) * 16);
}
struct EpiIn {
    static constexpr bool PERM = true, AFTER_DRAIN = false;
    bf16_t* Z; bf16_t* KST; bf16_t* VT; bf16_t* QF; bf16_t* KF; const float* Bc; LAS unsigned char* tsc;
    __device__ __forceinline__ void operator()(const f32x4 (&acc)[2][2][4][2], const pg8::Unit& u, int wr, int wc, int fr, int fq) const {
        const int row0 = u.pm * 256 + wr * 64 + fr + opaque_zero(), colt = u.pn * 256, col0 = colt + wc * 32 + 8 * fq;
        const int lane_ = fq * 16 + fr;
        if (colt < 1024) {
            const int hd = colt >> 8, ch0 = wc * 32 + 8 * fq;
#pragma unroll
            for (int ai = 0; ai < 2; ++ai)
#pragma unroll
                for (int mh = 0; mh < 2; ++mh) {
                    f32x4 bb[2][2], ll[2][2];
#pragma unroll
                    for (int mm = 0; mm < 2; ++mm) { const int r = row0 + ai * 128 + (mh * 2 + mm) * 16;
                        const float* bp = Bc + (size_t)r * 512 + hd * 128 + ch0; const float* lp = Bc + (size_t)(r | 63) * 512 + hd * 128 + ch0;
                        bb[mm][0] = *(const f32x4*)bp; bb[mm][1] = *(const f32x4*)(bp + 4); ll[mm][0] = *(const f32x4*)lp; ll[mm][1] = *(const f32x4*)(lp + 4); }
#pragma unroll
                    for (int mm = 0; mm < 2; ++mm) { const int m = mh * 2 + mm, r = row0 + ai * 128 + m * 16;
                        const f32x4 q0 = acc[ai][0][m][0], q1 = acc[ai][0][m][1], k0 = acc[ai][1][m][0], k1 = acc[ai][1][m][1], b0 = bb[mm][0], b1 = bb[mm][1], l0 = ll[mm][0], l1 = ll[mm][1];
                        const size_t ubase = (size_t)(((r >> 11) * 4 + hd) * 32 + ((r >> 6) & 31)) * 8192; const int foff = ((((r >> 4) & 3) * 4 + wc) * 64 + fq * 16 + (r & 15)) * 8;
                        float e0[4], e1[4];
#pragma unroll
                        for (int j = 0; j < 4; ++j) { e0[j] = __expf(b0[j]); e1[j] = __expf(b1[j]); }
                        {   u32x4 w; w.x = cvt_pk_bf16(q0[0] * QSCALE * e0[0], q0[1] * QSCALE * e0[1]); w.y = cvt_pk_bf16(q0[2] * QSCALE * e0[2], q0[3] * QSCALE * e0[3]);
                            w.z = cvt_pk_bf16(q1[0] * QSCALE * e1[0], q1[1] * QSCALE * e1[1]); w.w = cvt_pk_bf16(q1[2] * QSCALE * e1[2], q1[3] * QSCALE * e1[3]);
                            *(u32x4*)(QF + ubase + foff) = w; }
                        float kv[8];
#pragma unroll
                        for (int j = 0; j < 4; ++j) { kv[j] = k0[j] * __expf(l0[j] - b0[j]); kv[j + 4] = k1[j] * __expf(l1[j] - b1[j]); }
                        const u32x4 tv = wave_transpose_16x32(tsc + (wr * 4 + wc) * 1152, fr, fq, kv);
                        const int kk_ = wc * 32 + (lane_ >> 1), rf = r - fr, jb_ = ((rf & 63) >> 3) + (lane_ & 1);
                        *(u32x4*)(KST + ubase + ((((kk_ >> 4) * 2 + (jb_ >> 2)) * 64 + (jb_ & 3) * 16 + (kk_ & 15)) * 8)) = tv;
                        {   u32x4 w; w.x = cvt_pk_bf16(k0[0] * __expf(-b0[0]), k0[1] * __expf(-b0[1])); w.y = cvt_pk_bf16(k0[2] * __expf(-b0[2]), k0[3] * __expf(-b0[3]));
                            w.z = cvt_pk_bf16(k1[0] * __expf(-b1[0]), k1[1] * __expf(-b1[1])); w.w = cvt_pk_bf16(k1[2] * __expf(-b1[2]), k1[3] * __expf(-b1[3]));
                            *(u32x4*)(KF + ubase + foff) = w; } }
                    __builtin_amdgcn_sched_barrier(0);
                }
        } else if (colt < 2048) {
#pragma unroll
            for (int ai = 0; ai < 2; ++ai)
#pragma unroll
                for (int m = 0; m < 4; ++m)
#pragma unroll
                    for (int bj = 0; bj < 2; ++bj) { const int r = row0 + ai * 128 + m * 16; const f32x4 v0 = acc[ai][bj][m][0], v1 = acc[ai][bj][m][1];
                        float vv[8];
#pragma unroll
                        for (int j = 0; j < 4; ++j) { vv[j] = v0[j]; vv[j + 4] = v1[j]; }
                        const u32x4 tv = wave_transpose_16x32(tsc + (wr * 4 + wc) * 1152, fr, fq, vv);
                        const int hv = colt - 1024 + bj * 128 + wc * 32 + (lane_ >> 1), rf = r - fr, vv_ = hv & 255, jb_ = ((rf & 63) >> 3) + (lane_ & 1);
                        *(u32x4*)(VT + (size_t)(((rf >> 11) * 4 + (hv >> 8)) * 32 + ((rf >> 6) & 31)) * 16384 + ((((vv_ >> 4) * 2 + (jb_ >> 2)) * 64 + (jb_ & 3) * 16 + (vv_ & 15)) * 8)) = tv; }
        } else if (colt >= 3072 && colt < 5120) {
            const bool zt = colt < 4096; const int cz = (zt ? ZZ : ZCG) + (((colt - 3072) >> 8) & 3) * 128 + wc * 32 + 8 * fq;
#pragma unroll
            for (int ai = 0; ai < 2; ++ai)
#pragma unroll
                for (int m = 0; m < 4; ++m) { const f32x4 a0 = acc[ai][0][m][0], a1 = acc[ai][0][m][1], b0 = acc[ai][1][m][0], b1 = acc[ai][1][m][1];
                    float o[8];
#pragma unroll
                    for (int j = 0; j < 4; ++j) { o[j] = a0[j] * (zt ? b0[j] : siluf_(b0[j])); o[j + 4] = a1[j] * (zt ? b1[j] : siluf_(b1[j])); }
                    u32x4 w; w.x = cvt_pk_bf16(o[0], o[1]); w.y = cvt_pk_bf16(o[2], o[3]); w.z = cvt_pk_bf16(o[4], o[5]); w.w = cvt_pk_bf16(o[6], o[7]);
                    __builtin_nontemporal_store(w, (u32x4*)(Z + (size_t)(row0 + ai * 128 + m * 16) * NZ + cz)); }
        } else {
            const int cs = colt < 3072 ? 2048 : 3072;
#pragma unroll
            for (int ai = 0; ai < 2; ++ai)
#pragma unroll
                for (int m = 0; m < 4; ++m)
#pragma unroll
                    for (int bj = 0; bj < 2; ++bj) { const f32x4 v0 = acc[ai][bj][m][0], v1 = acc[ai][bj][m][1];
                        u32x4 w; w.x = cvt_pk_bf16(v0[0], v0[1]); w.y = cvt_pk_bf16(v0[2], v0[3]); w.z = cvt_pk_bf16(v1[0], v1[1]); w.w = cvt_pk_bf16(v1[2], v1[3]);
                        __builtin_nontemporal_store(w, (u32x4*)(Z + (size_t)(row0 + ai * 128 + m * 16) * NZ + col0 - cs + bj * 128)); }
        }
    }
};
template <int SECOND> struct EpiMerge {
    static constexpr bool PERM = true, AFTER_DRAIN = false;
    bf16_t* MG; const bf16_t* Z;
    __device__ __forceinline__ void operator()(const f32x4 (&acc)[2][2][4][2], const pg8::Unit& u, int wr, int wc, int fr, int fq) const {
        const int row0 = u.pm * 256 + wr * 64 + fr + opaque_zero(), col0 = u.pn * 256 + wc * 32 + 8 * fq;
#pragma unroll
        for (int ai = 0; ai < 2; ++ai) {
            u32x4 g[4][2], t[4][2];
#pragma unroll
            for (int m = 0; m < 4; ++m)
#pragma unroll
                for (int bj = 0; bj < 2; ++bj) { const size_t r = (size_t)(row0 + ai * 128 + m * 16); const int c = col0 + bj * 128;
                    g[m][bj] = *(const u32x4*)(Z + r * NZ + (SECOND ? ZMC : ZMG) + c);
                    if (SECOND) t[m][bj] = *(const u32x4*)(MG + r * 1024 + c); }
#pragma unroll
            for (int m = 0; m < 4; ++m)
#pragma unroll
                for (int bj = 0; bj < 2; ++bj) { const size_t r = (size_t)(row0 + ai * 128 + m * 16); const int c = col0 + bj * 128; const f32x4 v0 = acc[ai][bj][m][0], v1 = acc[ai][bj][m][1];
                    const u32x4 gg = g[m][bj]; float o[8];
                    o[0] = v0[0] * sigmoidf_(bflo(gg.x)); o[1] = v0[1] * sigmoidf_(bfhi(gg.x)); o[2] = v0[2] * sigmoidf_(bflo(gg.y)); o[3] = v0[3] * sigmoidf_(bfhi(gg.y));
                    o[4] = v1[0] * sigmoidf_(bflo(gg.z)); o[5] = v1[1] * sigmoidf_(bfhi(gg.z)); o[6] = v1[2] * sigmoidf_(bflo(gg.w)); o[7] = v1[3] * sigmoidf_(bfhi(gg.w));
                    if (SECOND) { const u32x4 tt = t[m][bj];
                        o[0] += bflo(tt.x); o[1] += bfhi(tt.x); o[2] += bflo(tt.y); o[3] += bfhi(tt.y); o[4] += bflo(tt.z); o[5] += bfhi(tt.z); o[6] += bflo(tt.w); o[7] += bfhi(tt.w); }
                    u32x4 w; w.x = cvt_pk_bf16(o[0], o[1]); w.y = cvt_pk_bf16(o[2], o[3]); w.z = cvt_pk_bf16(o[4], o[5]); w.w = cvt_pk_bf16(o[6], o[7]);
                    *(u32x4*)(MG + r * 1024 + c) = w; }
            __builtin_amdgcn_sched_barrier(0);
        }
    }
};
struct EpiGate {
    static constexpr bool PERM = true, AFTER_DRAIN = false;
    bf16_t* GO; const float* ada;
    __device__ __forceinline__ void operator()(const f32x4 (&acc)[2][2][4][2], const pg8::Unit& u, int wr, int wc, int fr, int fq) const {
        const int row0 = u.pm * 256 + wr * 64 + fr + opaque_zero(), col0 = u.pn * 256 + wc * 32 + 8 * fq;
        const float* gate = ada + (size_t)(u.pm >> 3) * 3072 + 2048 + col0;
        f32x4 gv[2][2];
#pragma unroll
        for (int bj = 0; bj < 2; ++bj) { gv[bj][0] = *(const f32x4*)(gate + bj * 128); gv[bj][1] = *(const f32x4*)(gate + bj * 128 + 4); }
#pragma unroll
        for (int ai = 0; ai < 2; ++ai)
#pragma unroll
            for (int m = 0; m < 4; ++m)
#pragma unroll
                for (int bj = 0; bj < 2; ++bj) { const f32x4 v0 = acc[ai][bj][m][0] * gv[bj][0], v1 = acc[ai][bj][m][1] * gv[bj][1];
                    u32x4 w; w.x = cvt_pk_bf16(v0[0], v0[1]); w.y = cvt_pk_bf16(v0[2], v0[3]); w.z = cvt_pk_bf16(v1[0], v1[1]); w.w = cvt_pk_bf16(v1[2], v1[3]);
                    *(u32x4*)(GO + (size_t)(row0 + ai * 128 + m * 16) * 1024 + col0 + bj * 128) = w; }
    }
};
DI f32x4 small_mma(const bf16_t* A, int lda, const bf16_t* Bt, int K, int arow0, int n0, int fr, int fq) {
    f32x4 acc = {0.f, 0.f, 0.f, 0.f};
    const bf16_t* ap = A + (size_t)(arow0 + fr) * lda + 8 * fq; const bf16_t* bp = Bt + (size_t)(n0 + fr) * K + 8 * fq;
#pragma unroll 16
    for (int k = 0; k < K; k += 32) acc = mfma16(*(const bf16x8*)(ap + k), *(const bf16x8*)(bp + k), acc);
    return acc;
}

__device__ __forceinline__ void phase2(const P& p, unsigned char* sm, int l) {
    {   pg8::Gemm g; g.A = wsb(p, OFF_U); g.Bt = wsb(p, OFF_WIN + l * SZ_WIN); g.M = TP; g.N = NW; g.K = 1024;
        pg8::StaticOrder S; S.init(TP, NW, (int)gridDim.x, (int)blockIdx.x);
        EpiIn E; E.Z = wsb(p, OFF_Z); E.KST = wsb(p, OFF_KST); E.VT = wsb(p, OFF_VT); E.QF = wsb(p, OFF_QF); E.KF = wsb(p, OFF_KF); E.Bc = wsf(p, OFF_B); E.tsc = (LAS unsigned char*)sm + 131072;
        pg8::gemm_phase<EpiIn, pg8::StaticOrder, false>((LAS unsigned char*)sm, g, S, E, nullptr); }
    const int tid = threadIdx.x + opaque_zero(), w = tid >> 6, lane = tid & 63, fr = lane & 15, fq = lane >> 4;
    for (int t = w * (int)gridDim.x + (int)blockIdx.x; t < (NW / 32) * 8; t += 8 * (int)gridDim.x) {
        const int ct = t >> 3, rt = t & 7;
        const bf16_t* ap = wsb(p, OFF_U) + (size_t)(TP + 16 * rt + fr) * 1024 + 8 * fq; const bf16_t* bp = wsb(p, OFF_WIN + l * SZ_WIN) + (size_t)(ct * 32 + fr) * 1024 + 8 * fq;
        f32x4 a0 = {0.f, 0.f, 0.f, 0.f}, a1 = {0.f, 0.f, 0.f, 0.f};
#pragma unroll 8
        for (int k = 0; k < 1024; k += 32) { const bf16x8 av = *(const bf16x8*)(ap + k); a0 = mfma16(av, *(const bf16x8*)(bp + k), a0); a1 = mfma16(av, *(const bf16x8*)(bp + 16 * 1024 + k), a1); }
#pragma unroll
        for (int j = 0; j < 4; ++j) { in_elem(p, TP + 16 * rt + 4 * fq + j, ct * 32 + fr, a0[j]); in_elem(p, TP + 16 * rt + 4 * fq + j, ct * 32 + 16 + fr, a1[j]); }
    }
}
__device__ __forceinline__ void phase4(const P& p, unsigned char* sm, int l) {
    bf16_t* MG = wsb(p, OFF_U);
    {   pg8::Gemm g; g.A = wsb(p, OFF_OG); g.Bt = wsb(p, OFF_WPA + l * SZ_WPA); g.M = TP; g.N = 1024; g.K = 1024;
        pg8::StaticOrder S; S.init(TP, 1024, (int)gridDim.x, (int)blockIdx.x);
        EpiMerge<0> E; E.MG = MG; E.Z = wsb(p, OFF_Z);
        pg8::gemm_phase<EpiMerge<0>, pg8::StaticOrder, false>((LAS unsigned char*)sm, g, S, E, nullptr); }
    asm volatile("s_waitcnt vmcnt(0)" ::: "memory"); __syncthreads();
    {   const int oz = opaque_zero(); pg8::Gemm g; g.A = wsb(p, OFF_YC) + oz; g.Bt = wsb(p, OFF_WPB + l * SZ_WPB) + oz; g.M = TP; g.N = 1024; g.K = 512 + oz; MG += oz;
        pg8::StaticOrder S; S.init(TP, 1024, (int)gridDim.x, (int)blockIdx.x);
        EpiMerge<1> E; E.MG = MG; E.Z = wsb(p, OFF_Z);
        pg8::gemm_phase<EpiMerge<1>, pg8::StaticOrder, false>((LAS unsigned char*)sm, g, S, E, nullptr); }
    const int tid = threadIdx.x + opaque_zero(), w = tid >> 6, lane = tid & 63, fr = lane & 15, fq = lane >> 4;
    for (int t = w * (int)gridDim.x + (int)blockIdx.x; t < 512; t += 8 * (int)gridDim.x) { const int it = t >> 3, rt = t & 7;
        const f32x4 a = small_mma(wsb(p, OFF_OG) + (size_t)TP * 1024, 1024, wsb(p, OFF_WPA + l * SZ_WPA), 1024, 16 * rt, it * 16, fr, fq);
        const f32x4 b = small_mma(wsb(p, OFF_YC) + (size_t)TP * 512, 512, wsb(p, OFF_WPB + l * SZ_WPB), 512, 16 * rt, it * 16, fr, fq);
#pragma unroll
        for (int j = 0; j < 4; ++j) { const int r = TP + 16 * rt + 4 * fq + j, c = it * 16 + fr; const bf16_t* z = wsb(p, OFF_Z) + (size_t)r * NZ;
            MG[(size_t)r * 1024 + c] = f2bf(sigmoidf_(bf2f(z[ZMG + c])) * a[j] + sigmoidf_(bf2f(z[ZMC + c])) * b[j]); }
    }
}
__device__ __forceinline__ void phase5(const P& p, unsigned char* sm, int l) {
    bf16_t* GO = wsb(p, OFF_Z); const float* ada = wsf(p, OFF_ADA) + (size_t)l * NADA * 3072;
    {   pg8::Gemm g; g.A = wsb(p, OFF_U); g.Bt = wsb(p, OFF_WO + l * SZ_WO); g.M = TP; g.N = 1024; g.K = 1024;
        pg8::StaticOrder S; S.init(TP, 1024, (int)gridDim.x, (int)blockIdx.x);
        EpiGate E; E.GO = GO; E.ada = ada;
        pg8::gemm_phase<EpiGate, pg8::StaticOrder, false>((LAS unsigned char*)sm, g, S, E, nullptr); }
    const int tid = threadIdx.x + opaque_zero(), w = tid >> 6, lane = tid & 63, fr = lane & 15, fq = lane >> 4;
#ifndef NO_SMALL
    for (int t = w * (int)gridDim.x + (int)blockIdx.x; t < 512; t += 8 * (int)gridDim.x) { const int it = t >> 3, rt = t & 7;
        const f32x4 a = small_mma(wsb(p, OFF_U) + (size_t)TP * 1024, 1024, wsb(p, OFF_WO + l * SZ_WO), 1024, 16 * rt, it * 16, fr, fq);
#pragma unroll
        for (int j = 0; j < 4; ++j) { const int r = TP + 16 * rt + 4 * fq + j, c = it * 16 + fr;
            GO[(size_t)r * 1024 + c] = f2bf(ada[(size_t)ada_row(r) * 3072 + 2048 + c] * a[j]); }
    }
#endif
}

DI bf16x8 cat8(u32x2 lo, u32x2 hi) { u32x4 v; v.x = lo.x; v.y = lo.y; v.z = hi.x; v.w = hi.y; return __builtin_bit_cast(bf16x8, v); }
__device__ __forceinline__ void gla_state(const P& p, int l, int bh, int s) {
    const int tid = threadIdx.x + opaque_zero(), w = tid >> 6, lane = tid & 63, fr = lane & 15, fq = lane >> 4;
    const int b = bh >> 2, h = bh & 3;
    const bf16_t* KT = wsb(p, OFF_KST) + (size_t)bh * 32 * 8192 + ((w * 2) * 64 + lane) * 8;
    const bf16_t* VT = wsb(p, OFF_VT) + (size_t)bh * 32 * 16384 + ((2 * s * 2) * 64 + lane) * 8;
    const float* DB = wsf(p, OFF_B) + ((size_t)b * SEQ + 63) * 512 + h * 128 + 16 * w + 4 * fq;
    bf16_t* SP = (bf16_t*)(p.out + OUT_Y) + (size_t)bh * 32 * 32768 + (((2 * s) * 4 + (w >> 1)) * 64 + (2 * (w & 1) + (fq >> 1)) * 16 + fr) * 8 + 4 * (fq & 1);
    f32x4 S0 = {0.f, 0.f, 0.f, 0.f}, S1 = {0.f, 0.f, 0.f, 0.f};
    bf16x8 ra[4][2], rv[4][4]; f32x4 rd[4];
#define GS_LD(u, c) do { const bf16_t* k_ = KT + (size_t)(c) * 8192; const bf16_t* v_ = VT + (size_t)(c) * 16384; \
        ra[u][0] = *(const bf16x8*)k_; ra[u][1] = *(const bf16x8*)(k_ + 512); \
        rv[u][0] = *(const bf16x8*)v_; rv[u][1] = *(const bf16x8*)(v_ + 512); rv[u][2] = *(const bf16x8*)(v_ + 1024); rv[u][3] = *(const bf16x8*)(v_ + 1024 + 512); \
        rd[u] = *(const f32x4*)(DB + (size_t)(c) * 64 * 512); } while (0)
    GS_LD(0, 0); GS_LD(1, 1); GS_LD(2, 2); GS_LD(3, 3);
    for (int c = 0; c < SEQ / 64; c += 4) {
#pragma unroll
        for (int u = 0; u < 4; ++u) {
            u32x2 t0, t1; t0.x = cvt_pk_bf16(S0[0], S0[1]); t0.y = cvt_pk_bf16(S0[2], S0[3]); t1.x = cvt_pk_bf16(S1[0], S1[1]); t1.y = cvt_pk_bf16(S1[2], S1[3]);
            bf16_t* sp = SP + (size_t)(c + u) * 32768;
            *(u32x2*)sp = t0; *(u32x2*)(sp + 2048) = t1;
            f32x4 d; d[0] = __expf(rd[u][0]); d[1] = __expf(rd[u][1]); d[2] = __expf(rd[u][2]); d[3] = __expf(rd[u][3]);
            S0 *= d; S1 *= d;
            S0 = mfma16(ra[u][0], rv[u][0], S0); S0 = mfma16(ra[u][1], rv[u][1], S0);
            S1 = mfma16(ra[u][0], rv[u][2], S1); S1 = mfma16(ra[u][1], rv[u][3], S1);
            if (c + u + 4 < SEQ / 64) GS_LD(u, c + u + 4);
        }
    }
#undef GS_LD
    float* So = p.out + OUT_GP + ((size_t)l * 32 + bh) * 128 * 256 + (size_t)(16 * w + 4 * fq) * 256 + 32 * s + fr;
#pragma unroll
    for (int e = 0; e < 4; ++e) { So[e * 256] = S0[e]; So[e * 256 + 16] = S1[e]; }
}
__device__ __forceinline__ void gla_out(const P& p, unsigned char* sm, int l, int unit) {
    const int tid = threadIdx.x + opaque_zero(), w = tid >> 6, lane = tid & 63, fr = lane & 15, fq = lane >> 4;
    LAS unsigned char* L = (LAS unsigned char*)sm;
    constexpr int oAT = 0, oRS = 9216, oRSTD = 11264, oOT = 12288;
    const int bh = unit >> 5, c = unit & 31, b = bh >> 2, h = bh & 3;
    const size_t r0 = (size_t)b * SEQ + (size_t)c * 64;
    const bf16_t* Z = wsb(p, OFF_Z);
    const bf16_t* Zq = wsb(p, OFF_QF) + (size_t)unit * 8192 + lane * 8;
    const bf16_t* Zk = wsb(p, OFF_KF) + (size_t)unit * 8192 + lane * 8;
    const bf16_t* VTu = wsb(p, OFF_VT) + (size_t)unit * 16384 + ((2 * w * 2) * 64 + lane) * 8;
    const bf16_t* SPu = (const bf16_t*)(p.out + OUT_Y) + (size_t)unit * 32768 + ((2 * w * 4) * 64 + lane) * 8;
    const bf16_t* gg = Z + (r0 + (tid >> 5)) * NZ + ZG + h * 256 + (tid & 31) * 8;
    bf16_t* go = wsb(p, OFF_OG) + (r0 + (tid >> 5)) * 1024 + h * 256 + (tid & 31) * 8;
    const int tb = (fr * 72 + 8 * fq) * 2;
    const float gn0 = p.gng[l * 256 + 32 * w + fr], gn1 = p.gng[l * 256 + 32 * w + 16 + fr];
    __syncthreads();
    {   const int it = w >> 1;
#pragma unroll
        for (int jj = 0; jj < 2; ++jj) { const int jt = (w & 1) * 2 + jj; f32x4 a = {0.f, 0.f, 0.f, 0.f};
            if (jt <= it) {
#pragma unroll
                for (int ks = 0; ks < 4; ++ks) a = mfma16(*(const bf16x8*)(Zq + (it * 4 + ks) * 512), *(const bf16x8*)(Zk + (jt * 4 + ks) * 512), a); }
#pragma unroll
            for (int e = 0; e < 4; ++e) { const int i = it * 16 + 4 * fq + e, j = jt * 16 + fr; *(LAS bf16_t*)(L + oAT + (i * 72 + j) * 2) = (j <= i) ? f2bf(a[e]) : (bf16_t)0; } } }
    u32x4 rg[4];
#pragma unroll
    for (int e = 0; e < 4; ++e) rg[e] = *(const u32x4*)(gg + (size_t)(16 * e) * NZ);
    bf16x8 vb[2][2];
#pragma unroll
    for (int nt = 0; nt < 2; ++nt)
#pragma unroll
        for (int js = 0; js < 2; ++js) vb[nt][js] = *(const bf16x8*)(VTu + nt * 1024 + js * 512);
    bf16x8 sbr[4][2], qfr[4][4];
#pragma unroll
    for (int ks = 0; ks < 4; ++ks) { sbr[ks][0] = *(const bf16x8*)(SPu + ks * 512); sbr[ks][1] = *(const bf16x8*)(SPu + 2048 + ks * 512);
#pragma unroll
        for (int it = 0; it < 4; ++it) qfr[ks][it] = *(const bf16x8*)(Zq + (it * 4 + ks) * 512); }
    __syncthreads();
    f32x4 o[4][2];
#pragma unroll
    for (int it = 0; it < 4; ++it) { o[it][0] = (f32x4){0.f, 0.f, 0.f, 0.f}; o[it][1] = (f32x4){0.f, 0.f, 0.f, 0.f}; }
#pragma unroll
    for (int ks = 0; ks < 4; ++ks) {
#pragma unroll
        for (int it = 0; it < 4; ++it) { o[it][0] = mfma16(qfr[ks][it], sbr[ks][0], o[it][0]); o[it][1] = mfma16(qfr[ks][it], sbr[ks][1], o[it][1]); } }
#pragma unroll
    for (int it = 0; it < 4; ++it)
#pragma unroll
        for (int js = 0; js < 2; ++js) { if (js == 1 && it < 2) continue;
            const bf16x8 a = *(const LAS bf16x8*)(L + oAT + tb + it * 16 * 144 + js * 64);
            o[it][0] = mfma16(a, vb[0][js], o[it][0]); o[it][1] = mfma16(a, vb[1][js], o[it][1]); }
#pragma unroll
    for (int it = 0; it < 4; ++it)
#pragma unroll
        for (int e = 0; e < 4; ++e) { float s = o[it][0][e] * o[it][0][e] + o[it][1][e] * o[it][1][e];
            s += __shfl_xor(s, 1); s += __shfl_xor(s, 2); s += __shfl_xor(s, 4); s += __shfl_xor(s, 8);
            if (fr == 0) *(LAS float*)(L + oRS + (w * 64 + it * 16 + 4 * fq + e) * 4) = s; }
    __syncthreads();
    if (tid < 64) { float s = 0.f;
#pragma unroll
        for (int ww = 0; ww < 8; ++ww) s += *(const LAS float*)(L + oRS + (ww * 64 + tid) * 4);
        *(LAS float*)(L + oRSTD + tid * 4) = rsqrtf(s * (1.0f / 256.0f) + EPS); }
    __syncthreads();
#pragma unroll
    for (int it = 0; it < 4; ++it) { const f32x4 rsd = *(const LAS f32x4*)(L + oRSTD + (it * 16 + 4 * fq) * 4);
#pragma unroll
        for (int e = 0; e < 4; ++e) { const int i = it * 16 + 4 * fq + e;
            *(LAS bf16_t*)(L + oOT + (i * 264 + 32 * w + fr) * 2) = f2bf(o[it][0][e] * rsd[e] * gn0); *(LAS bf16_t*)(L + oOT + (i * 264 + 32 * w + 16 + fr) * 2) = f2bf(o[it][1][e] * rsd[e] * gn1); } }
    __syncthreads();
#pragma unroll
    for (int e = 0; e < 4; ++e) { const u32x4 ov = *(const LAS u32x4*)(L + oOT + (((tid >> 5) + 16 * e) * 264 + (tid & 31) * 8) * 2); const u32x4 g = rg[e];
        u32x4 r; r.x = cvt_pk_bf16(bflo(ov.x) * siluf_(bflo(g.x)), bfhi(ov.x) * siluf_(bfhi(g.x))); r.y = cvt_pk_bf16(bflo(ov.y) * siluf_(bflo(g.y)), bfhi(ov.y) * siluf_(bfhi(g.y)));
        r.z = cvt_pk_bf16(bflo(ov.z) * siluf_(bflo(g.z)), bfhi(ov.z) * siluf_(bfhi(g.z))); r.w = cvt_pk_bf16(bflo(ov.w) * siluf_(bflo(g.w)), bfhi(ov.w) * siluf_(bfhi(g.w)));
        *(u32x4*)(go + (size_t)(16 * e) * 1024) = r; }
}
DI void unpack8(const u32x4 a, float (&f)[8]) { f[0] = bflo(a.x); f[1] = bfhi(a.x); f[2] = bflo(a.y); f[3] = bfhi(a.y); f[4] = bflo(a.z); f[5] = bfhi(a.z); f[6] = bflo(a.w); f[7] = bfhi(a.w); }
DI void conv_piece(const P& p, int l, int r, int cgp, const float (&w0)[8], const float (&w1)[8], const float (&w2)[8], bool prompt) {
    float z0[8], z1[8], z2[8], cg[8];
    if (prompt) { const bf16_t* zr = wsb(p, OFF_Z) + (size_t)r * NZ; const int t = r & (SEQ - 1);
        unpack8(*(const u32x4*)(zr + ZZ + cgp * 8), z0); unpack8(*(const u32x4*)(zr + ZCG + cgp * 8), cg);
#pragma unroll
        for (int e = 0; e < 8; ++e) { z1[e] = 0.f; z2[e] = 0.f; }
        if (t >= 1) unpack8(*(const u32x4*)(zr - NZ + ZZ + cgp * 8), z1);
        if (t >= 2) unpack8(*(const u32x4*)(zr - 2 * NZ + ZZ + cgp * 8), z2);
        if (t >= SEQ - 2) { float* dst = p.out + OUT_CP + (((size_t)l * NBATCH + (r >> 11)) * 2 + (t - (SEQ - 2))) * 512 + cgp * 8;
            *(float4*)dst = (float4){z0[0], z0[1], z0[2], z0[3]}; *(float4*)(dst + 4) = (float4){z0[4], z0[5], z0[6], z0[7]}; }
    } else { const int sr = r - TP; const bf16_t* zs = wsb(p, OFF_ZS) + (size_t)sr * ZSW + 2048 + cgp * 8;
        float a[8], b[8];
        unpack8(*(const u32x4*)zs, a); unpack8(*(const u32x4*)(zs + 512), b);
#pragma unroll
        for (int e = 0; e < 8; ++e) z0[e] = a[e] * b[e];
        unpack8(*(const u32x4*)(zs + 1024), a); unpack8(*(const u32x4*)(zs + 1536), b);
#pragma unroll
        for (int e = 0; e < 8; ++e) cg[e] = a[e] * siluf_(b[e]);
        const float* b0 = p.sconv + (((size_t)l * SB + sr) * 2 + 0) * 512 + cgp * 8; const float* b1 = b0 + 512;
        const float4 a0 = *(const float4*)b0, a1 = *(const float4*)(b0 + 4), c0 = *(const float4*)b1, c1 = *(const float4*)(b1 + 4);
        z2[0] = a0.x; z2[1] = a0.y; z2[2] = a0.z; z2[3] = a0.w; z2[4] = a1.x; z2[5] = a1.y; z2[6] = a1.z; z2[7] = a1.w;
        z1[0] = c0.x; z1[1] = c0.y; z1[2] = c0.z; z1[3] = c0.w; z1[4] = c1.x; z1[5] = c1.y; z1[6] = c1.z; z1[7] = c1.w;
        float* dst = p.out + OUT_CS + (((size_t)l * SB + sr) * 2) * 512 + cgp * 8;
        *(float4*)dst = c0; *(float4*)(dst + 4) = c1;
        *(float4*)(dst + 512) = (float4){z0[0], z0[1], z0[2], z0[3]}; *(float4*)(dst + 516) = (float4){z0[4], z0[5], z0[6], z0[7]}; }
    float y[8];
#pragma unroll
    for (int e = 0; e < 8; ++e) y[e] = cg[e] * (w0[e] * z2[e] + w1[e] * z1[e] + w2[e] * z0[e]);
    u32x4 o; o.x = cvt_pk_bf16(y[0], y[1]); o.y = cvt_pk_bf16(y[2], y[3]); o.z = cvt_pk_bf16(y[4], y[5]); o.w = cvt_pk_bf16(y[6], y[7]);
    *(u32x4*)(wsb(p, OFF_YC) + (size_t)r * 512 + cgp * 8) = o;
}
__device__ __forceinline__ void p3_other(const P& p, unsigned char* sm, int l, int first, int nblk) {
    const int tid = threadIdx.x + opaque_zero(), w = tid >> 6, lane = tid & 63;
    float* qf = (float*)sm; float* kif = qf + 128; float* ksf = kif + 128; float* af = ksf + 128; float* vf = af + 128; float* OP = vf + 256; float* red = OP + 2048;
    const bf16_t* Z = wsb(p, OFF_Z);
    for (int it = (int)blockIdx.x - first; it < 512 + 256; it += nblk) {
        if (it < 512) {
            const int sb = it >> 2, h = it & 3, r = TP + sb;
            __syncthreads();
            const bf16_t* ZS = wsb(p, OFF_ZS) + (size_t)sb * ZSW;
            if (tid < 128) { qf[tid] = bf2f(ZS[ZQ + h * 128 + tid]); kif[tid] = bf2f(ZS[ZK + h * 128 + tid]);
                ksf[tid] = bf2f(wsb(p, OFF_KST)[(size_t)r * 512 + h * 128 + tid]); af[tid] = __expf(wsf(p, OFF_B)[(size_t)r * 512 + h * 128 + tid]); }
            else if (tid < 384) vf[tid - 128] = bf2f(ZS[ZV + h * 256 + tid - 128]);
            __syncthreads();
            const float* S0 = p.sgla + ((((size_t)l * SB + sb) * 4 + h) * 128) * 256; float* S1 = p.out + OUT_GS + ((((size_t)l * SB + sb) * 4 + h) * 128) * 256;
            const float4 v4 = *(const float4*)(vf + 4 * lane); float4 op = {0.f, 0.f, 0.f, 0.f};
            f32x4 sv[16];
#pragma unroll
            for (int kk = 0; kk < 16; ++kk) sv[kk] = __builtin_nontemporal_load((const f32x4*)(S0 + (size_t)(w * 16 + kk) * 256 + 4 * lane));
#pragma unroll
            for (int kk = 0; kk < 16; ++kk) { const int k = w * 16 + kk; const f32x4 s = sv[kk]; const float a = af[k], ks = ksf[k], q = qf[k];
                f32x4 sn; sn[0] = fmaf(a, s[0], ks * v4.x); sn[1] = fmaf(a, s[1], ks * v4.y); sn[2] = fmaf(a, s[2], ks * v4.z); sn[3] = fmaf(a, s[3], ks * v4.w);
                __builtin_nontemporal_store(sn, (f32x4*)(S1 + (size_t)k * 256 + 4 * lane));
                op.x = fmaf(q, s[0], op.x); op.y = fmaf(q, s[1], op.y); op.z = fmaf(q, s[2], op.z); op.w = fmaf(q, s[3], op.w); }
            *(float4*)(OP + w * 256 + 4 * lane) = op;
            __syncthreads();
            float ov = 0.f;
            if (tid < 256) { float qk = 0.f;
                for (int k = 0; k < 128; ++k) qk = fmaf(qf[k], kif[k], qk);
                ov = qk * vf[tid];
#pragma unroll
                for (int ww = 0; ww < 8; ++ww) ov += OP[ww * 256 + tid];
                const float ss = wave_sum(ov * ov); if (lane == 0) red[w] = ss; }
            __syncthreads();
            if (tid < 256) { const float rstd = rsqrtf((red[0] + red[1] + red[2] + red[3]) * (1.0f / 256.0f) + EPS);
                const float g = bf2f(Z[(size_t)r * NZ + ZG + h * 256 + tid]);
                wsb(p, OFF_OG)[(size_t)r * 1024 + h * 256 + tid] = f2bf(ov * rstd * p.gng[l * 256 + tid] * siluf_(g)); }
        } else {
            const int ch = it - 512, cgp = tid & 63;
            float w0[8], w1[8], w2[8];
#pragma unroll
            for (int e = 0; e < 8; ++e) { w0[e] = p.conv_w[(l * 3 + 0) * 512 + cgp * 8 + e]; w1[e] = p.conv_w[(l * 3 + 1) * 512 + cgp * 8 + e]; w2[e] = p.conv_w[(l * 3 + 2) * 512 + cgp * 8 + e]; }
#pragma unroll 2
            for (int e8 = 0; e8 < 8; ++e8) conv_piece(p, l, ch * 64 + (tid >> 6) + 8 * e8, cgp, w0, w1, w2, true);
            if (tid < 32) { const int cg2 = (ch & 1) * 32 + tid;
#pragma unroll
                for (int e = 0; e < 8; ++e) { w0[e] = p.conv_w[(l * 3 + 0) * 512 + cg2 * 8 + e]; w1[e] = p.conv_w[(l * 3 + 1) * 512 + cg2 * 8 + e]; w2[e] = p.conv_w[(l * 3 + 2) * 512 + cg2 * 8 + e]; }
                conv_piece(p, l, TP + (ch >> 1), cg2, w0, w1, w2, false); }
        }
    }
}
__device__ __forceinline__ void phase3a(const P& p, unsigned char* sm, int l) {
    for (int i = blockIdx.x; i < 256; i += gridDim.x) { const int x = i & 7, j = i >> 3; gla_state(p, l, x * 4 + (j >> 3), j & 7); }
#ifdef PROBE_GS
    __syncthreads(); for (int i = blockIdx.x; i < 256; i += gridDim.x) gla_state(p, l, i >> 3, i & 7);
#endif
    p3_other(p, sm, l, 0, (int)gridDim.x);
#ifdef PROBE_OT
    __syncthreads(); p3_other(p, sm, l, 0, (int)gridDim.x);
#endif
}
__device__ __forceinline__ void phase3b(const P& p, unsigned char* sm, int l) {
    for (int u = blockIdx.x; u < 1024; u += gridDim.x) gla_out(p, sm, l, u);
}

__global__ void __launch_bounds__(NTHR, 2) fwd_mega(P p) {
    extern __shared__ __attribute__((aligned(16))) unsigned char smem[];
    cg::grid_group grid = cg::this_grid();
    volatile LAS unsigned* bst = (volatile LAS unsigned*)((LAS unsigned char*)smem + LDS_BYTES - 64);
    if (threadIdx.x < 16) bst[threadIdx.x] = 0u;
    __syncthreads();
    if (p.ph_hi > 1000) grid.sync();
#if USE_XCD_BAR
    XcdBarrier bar; bar.bar = (unsigned*)(p.ws + OFF_CTL); bar.x = 0; bar.st = nullptr;
    if (p.ph_hi - p.ph_lo > 1) bar = xcd_barrier_post((unsigned*)(p.ws + OFF_CTL), bst);
#endif
#ifndef PH_MASK
#define PH_MASK 0xffff
#endif
#define PHON(k) ((PH_MASK >> (k)) & 1)
#if USE_XCD_BAR
#define SEAM(k) do { if ((k) + 1 < p.ph_hi) xcd_barrier(bar); } while (0)
#else
#define SEAM(k) do { if ((k) + 1 < p.ph_hi) grid.sync(); } while (0)
#endif
#ifndef REPEAT_PH
#define REPEAT_PH -1
#endif
#ifndef REPEAT_BAR
#define REPEAT_BAR 0
#endif
#define RUN(k, call) do { if (p.ph_lo <= (k) && (k) < p.ph_hi) { if (PHON(k)) { call; } if (REPEAT_PH == (k)) { __syncthreads(); call; } SEAM(k); if (REPEAT_BAR && (k) > 0) { SEAM(k); SEAM(k); } } } while (0)
    RUN(0, phase0(p, smem));
    RUN(1, phase1(p, smem, 0, 0); p0_convert(p, smem));
    RUN(2, phase2(p, smem, 0));
    RUN(3, phase3a(p, smem, 0));
    RUN(4, phase3b(p, smem, 0));
    RUN(5, phase4(p, smem, 0));
    RUN(6, phase5(p, smem, 0));
    RUN(7, phase1(p, smem, 1, 1));
    RUN(8, phase2(p, smem, 1));
    RUN(9, phase3a(p, smem, 1));
    RUN(10, phase3b(p, smem, 1));
    RUN(11, phase4(p, smem, 1));
    RUN(12, phase5(p, smem, 1));
    RUN(13, phase1(p, smem, 1, 2));
}

extern "C" void kernel_launch(void* const* d_in, const int* in_sizes, int n_in, void* d_out, int out_size, void* d_ws, size_t ws_size, hipStream_t stream) {
    static int grid = 0;
    if (grid == 0) {
        if (n_in != 18 || (size_t)out_size != OUT_END || ws_size < WS_END) { fprintf(stderr, "kernel_launch: unexpected sizes: n_in %d out %d (want %zu) ws %zu (want >= %zu)\n", n_in, out_size, (size_t)OUT_END, ws_size, (size_t)WS_END); grid = -1; return; }
        int dev = 0, cus = 0, per_cu = 0;
        hipGetDevice(&dev); hipDeviceGetAttribute(&cus, hipDeviceAttributeMultiprocessorCount, dev);
        if (hipFuncSetAttribute((const void*)fwd_mega, hipFuncAttributeMaxDynamicSharedMemorySize, LDS_BYTES) != hipSuccess) { fprintf(stderr, "kernel_launch: hipFuncSetAttribute failed\n"); grid = -1; return; }
        if (hipOccupancyMaxActiveBlocksPerMultiprocessor(&per_cu, (const void*)fwd_mega, NTHR, LDS_BYTES) != hipSuccess || per_cu < 1) { fprintf(stderr, "kernel_launch: occupancy query failed (%d)\n", per_cu); per_cu = 1; (void)hipGetLastError(); }
        grid = cus;
    }
    if (grid < 0) return;
    hipMemsetAsync((char*)d_ws + OFF_CTL, 0, SZ_CTL, stream);
    P p{};
    p.xp = (const float*)d_in[0]; p.xs = (const float*)d_in[1]; p.cp = (const float*)d_in[2]; p.cs = (const float*)d_in[3]; p.sgla = (const float*)d_in[4]; p.sconv = (const float*)d_in[5];
    p.w_ada = (const float*)d_in[6]; p.b_ada = (const float*)d_in[7]; p.w_in = (const float*)d_in[8]; p.w_a2 = (const float*)d_in[9]; p.b_a = (const float*)d_in[10]; p.gng = (const float*)d_in[11];
    p.conv_w = (const float*)d_in[12]; p.w_pa = (const float*)d_in[13]; p.w_pb = (const float*)d_in[14]; p.w_o = (const float*)d_in[15]; p.ln_g = (const float*)d_in[16]; p.ln_b = (const float*)d_in[17];
    p.out = (float*)d_out; p.ws = (unsigned char*)d_ws;
#if N_LAUNCH_PER_PHASE
    for (int ph = 0; ph < 14; ++ph) { p.ph_lo = ph; p.ph_hi = ph + 1; hipLaunchKernelGGL(fwd_mega, dim3(grid), dim3(NTHR), LDS_BYTES, stream, p); }
#else
    p.ph_lo = 0; p.ph_hi = 14;
    void* args[] = {&p};
    hipError_t e = hipLaunchCooperativeKernel((const void*)fwd_mega, dim3(grid), dim3(NTHR), args, LDS_BYTES, stream);
    if (e != hipSuccess) fprintf(stderr, "kernel_launch: cooperative launch failed: %s (grid %d)\n", hipGetErrorString(e), grid);
#endif
}
```

```cpp
#include <hip/hip_runtime.h>
#include <hip/hip_cooperative_groups.h>
#include <cstdio>
#include <cstdint>
namespace cg = cooperative_groups;
#ifndef USE_XCD_BAR
#define USE_XCD_BAR 1
#endif
#ifndef N_LAUNCH_PER_PHASE
#define N_LAUNCH_PER_PHASE 0
#endif
#define LAS __attribute__((address_space(3)))
__device__ __forceinline__ int opaque_zero() { int z; asm volatile("s_mov_b32 %0, 0" : "=s"(z)); return z; }
namespace pg8 {
#define PG8_LAS __attribute__((address_space(3)))
typedef unsigned short bf16_t;
typedef short bf16x8 __attribute__((ext_vector_type(8)));
typedef float f32x4 __attribute__((ext_vector_type(4)));
typedef unsigned u32x4 __attribute__((ext_vector_type(4)));
constexpr int BM = 256, BK = 64, HALF = 128, HTB = HALF * BK * 2  , STAGE_BYTES = 8 * HTB, NXCD = 8, WGM = 2;

__host__ __device__ __forceinline__ int lds_byte(int r, int c) { const int st = (r >> 4) * 2 + (c >> 5), rr = r & 15, cc = c & 31, ob = rr * 64 + cc * 2; return st * 1024 + (ob ^ (((ob >> 9) & 1) << 5)); }
__host__ __device__ __forceinline__ void stage_rc(int b, int& R, int& C) { const int st = b / 1024, sb = b % 1024, swz = sb ^ (((sb >> 9) & 1) << 5); R = (st >> 1) * 16 + swz / 64; C = (st & 1) * 32 + (swz % 64) / 2; }
__host__ __device__ __forceinline__ int perm32(int rho) { const int n = rho >> 4, i = rho & 15; return 8 * (i >> 2) + 4 * n + (i & 3); }
struct Unit { int pm, pn; };
struct Gemm { const bf16_t* A; const bf16_t* Bt; int M, N, K; };

struct StaticOrder {
    int nM, nN, nwg, G, c;
    __host__ __device__ void init(int M, int N, int G_, int c_) { nM = M / BM; nN = N / BM; nwg = nM * nN; G = G_; c = c_; }
    __host__ __device__ bool next(int i, Unit& u) const {
        const long L = (long)i * G + c; if (L >= nwg) return false;
        int wgid = (int)L; { const int q = nwg / NXCD, r = nwg % NXCD, xcd = wgid % NXCD, off = wgid / NXCD; wgid = (xcd < r ? xcd * (q + 1) : r * (q + 1) + (xcd - r) * q) + off; }
        const int nig = WGM * nN, gid = wgid / nig, fm = gid * WGM, gsz = (nM - fm) < WGM ? (nM - fm) : WGM;
        u.pm = fm + ((wgid % nig) % gsz); u.pn = (wgid % nig) / gsz; return true;
    }
    __device__ __forceinline__ void a_ready(const Unit&) const {}
    __device__ __forceinline__ void done(const Unit&) const {}
};
typedef __bf16 bf16x2n __attribute__((ext_vector_type(2)));
typedef float f32x2n __attribute__((ext_vector_type(2)));
__device__ __forceinline__ unsigned cvt_pk_bf16(float lo, float hi) { f32x2n v = {lo, hi}; bf16x2n b = __builtin_convertvector(v, bf16x2n); return __builtin_bit_cast(unsigned, b); }
template <class Epi, class Sched, bool STAMP = false>
__device__ __forceinline__ void gemm_phase(PG8_LAS unsigned char* lds, const Gemm g, const Sched& S, const Epi& E, unsigned long long* stamps) {
    const int tid = threadIdx.x + opaque_zero(), wid = __builtin_amdgcn_readfirstlane(tid >> 6), lane = tid & 63, wr = wid >> 2, wc = wid & 3, fr = lane & 15, fq = lane >> 4;
    const int K = g.K, nt = K / BK;
    int ts_lo = 0, ts_hi = 0, nts = 0; const unsigned long long rt_entry = STAMP ? (unsigned long long)wall_clock64() : 0ull;
#define PG8_STAMP() do { if (STAMP && wid == 0 && nts < 64) { const unsigned long long _c = (unsigned long long)clock64(); \
        ts_lo = (lane == nts) ? (int)(unsigned)_c : ts_lo; ts_hi = (lane == nts) ? (int)(unsigned)(_c >> 32) : ts_hi; ++nts; } } while (0)
    PG8_STAMP();
    unsigned voffA[2], voffB[2];
#pragma unroll
    for (int i = 0; i < 2; ++i) { int R, C; stage_rc(tid * 16 + i * 8192, R, C); const int Rb = Epi::PERM ? ((R & ~31) + perm32(R & 31)) : R;
        voffA[i] = (unsigned)(R * K + C) * 2u; voffB[i] = (unsigned)(Rb * K + C) * 2u; }
    const size_t kstep = (size_t)(BK * 2);
    const size_t hstep = (size_t)HALF * K * 2;
    const size_t tstep = 2 * hstep;
    const unsigned ldsw = (unsigned)wid * 1024u;
    const int aoff = lds_byte(wr * 64 + fr, fq * 8), boff = lds_byte(wc * 32 + fr, fq * 8);
#define PG8_SA(b, h) (((b) * 2 + (h)) * HTB)
#define PG8_SB(b, h) ((4 + (b) * 2 + (h)) * HTB)
#define PG8_STAGE(bufoff, gbase, voff) do { _Pragma("unroll") for (int _i = 0; _i < 2; ++_i) \
        __builtin_amdgcn_global_load_lds((const unsigned*)((const char*)(gbase) + (voff)[_i]), (PG8_LAS unsigned*)(lds + (bufoff) + ldsw + _i * 8192), 16, 0, 0); } while (0)
#define PG8_LDA(dst, b, h) do { _Pragma("unroll") for (int m = 0; m < 4; ++m) _Pragma("unroll") for (int k = 0; k < 2; ++k) dst[m][k] = *(const PG8_LAS bf16x8*)(lds + PG8_SA(b, h) + aoff + m * 2048 + k * 1024); } while (0)
#define PG8_LDB(dst, b, h) do { _Pragma("unroll") for (int n = 0; n < 2; ++n) _Pragma("unroll") for (int k = 0; k < 2; ++k) dst[n][k] = *(const PG8_LAS bf16x8*)(lds + PG8_SB(b, h) + boff + n * 2048 + k * 1024); } while (0)
#define PG8_MMA(ai, bj, At, Bt) do { __builtin_amdgcn_s_setprio(1); _Pragma("unroll") for (int m = 0; m < 4; ++m) _Pragma("unroll") for (int n = 0; n < 2; ++n) _Pragma("unroll") for (int k = 0; k < 2; ++k) \
        acc[ai][bj][m][n] = __builtin_amdgcn_mfma_f32_16x16x32_bf16(Bt[n][k], At[m][k], acc[ai][bj][m][n], 0, 0, 0); __builtin_amdgcn_s_setprio(0); } while (0)
#define PG8_WAIT_V(n) asm volatile("s_waitcnt vmcnt(" #n ")" ::: "memory")
#define PG8_WAIT_L(n) asm volatile("s_waitcnt lgkmcnt(" #n ")" ::: "memory")
#define PG8_BAR __builtin_amdgcn_s_barrier()
#define PG8_SCHED __builtin_amdgcn_sched_barrier(0)
    Unit cur, nxt; int ui = 0;
    if (!S.next(0, cur)) return;
    f32x4 acc[2][2][4][2];
#pragma unroll
    for (int a = 0; a < 2; ++a)
#pragma unroll
        for (int b = 0; b < 2; ++b)
#pragma unroll
            for (int m = 0; m < 4; ++m)
#pragma unroll
                for (int n = 0; n < 2; ++n) acc[a][b][m][n] = (f32x4){0.f, 0.f, 0.f, 0.f};
    bf16x8 At[4][2], B0[2][2], B1[2][2];
    const char* cA = (const char*)g.A + (size_t)cur.pm * tstep; const char* cB = (const char*)g.Bt + (size_t)cur.pn * tstep;
    S.a_ready(cur);
    PG8_STAGE(PG8_SB(0, 0), cB, voffB); PG8_STAGE(PG8_SA(0, 0), cA, voffA); PG8_STAGE(PG8_SB(0, 1), cB + hstep, voffB); PG8_STAGE(PG8_SA(0, 1), cA + hstep, voffA);
    if (wr == 1) PG8_BAR;
    PG8_WAIT_V(4); PG8_BAR;
    PG8_STAGE(PG8_SB(1, 0), cB + kstep, voffB); PG8_STAGE(PG8_SA(1, 0), cA + kstep, voffA); PG8_STAGE(PG8_SB(1, 1), cB + hstep + kstep, voffB);
    PG8_WAIT_V(6); PG8_BAR;
    PG8_STAMP();
    for (;;) {
        const bool has_next = S.next(ui + 1, nxt);
        const char* nA = has_next ? (const char*)g.A + (size_t)nxt.pm * tstep : cA; const char* nB = has_next ? (const char*)g.Bt + (size_t)nxt.pn * tstep : cB;
        for (int t = 0; t < nt; t += 2) {
            const bool last = (t == nt - 2);
            const char* a1 = cA + (size_t)(t + 1) * kstep;
            const char* a2 = last ? nA : cA + (size_t)(t + 2) * kstep; const char* b2 = last ? nB : cB + (size_t)(t + 2) * kstep;
            const char* a3 = a2 + kstep; const char* b3 = b2 + kstep;
            if (last && has_next) S.a_ready(nxt);
            PG8_LDB(B0, 0, 0); PG8_SCHED; PG8_LDA(At, 0, 0); PG8_STAGE(PG8_SA(1, 1), a1 + hstep, voffA);
            PG8_WAIT_L(8); PG8_BAR; PG8_WAIT_L(0); PG8_MMA(0, 0, At, B0); PG8_BAR; PG8_SCHED;
            PG8_LDB(B1, 0, 1); PG8_STAGE(PG8_SB(0, 0), b2, voffB);
            PG8_BAR; PG8_WAIT_L(0); PG8_MMA(0, 1, At, B1); PG8_BAR;
            PG8_LDA(At, 0, 1); PG8_STAGE(PG8_SA(0, 0), a2, voffA);
            PG8_BAR; PG8_WAIT_L(0); PG8_MMA(1, 0, At, B0); PG8_BAR; PG8_SCHED;
            PG8_STAGE(PG8_SB(0, 1), b2 + hstep, voffB);
            PG8_WAIT_V(6); PG8_BAR; PG8_MMA(1, 1, At, B1); PG8_BAR;
            PG8_LDB(B0, 1, 0); PG8_SCHED; PG8_LDA(At, 1, 0); PG8_STAGE(PG8_SA(0, 1), a2 + hstep, voffA);
            PG8_WAIT_L(8); PG8_BAR; PG8_WAIT_L(0); PG8_MMA(0, 0, At, B0); PG8_BAR; PG8_SCHED;
            PG8_LDB(B1, 1, 1); PG8_STAGE(PG8_SB(1, 0), b3, voffB);
            PG8_BAR; PG8_WAIT_L(0); PG8_MMA(0, 1, At, B1); PG8_BAR;
            PG8_LDA(At, 1, 1); PG8_STAGE(PG8_SA(1, 0), a3, voffA);
            PG8_BAR; PG8_WAIT_L(0); PG8_MMA(1, 0, At, B0); PG8_BAR; PG8_SCHED;
            PG8_STAGE(PG8_SB(1, 1), b3 + hstep, voffB);
            PG8_WAIT_V(6); PG8_BAR; PG8_MMA(1, 1, At, B1); PG8_BAR;
        }
        PG8_STAMP();
        if constexpr (!Epi::AFTER_DRAIN) { E(acc, cur, wr, wc, fr, fq); S.done(cur); }
        PG8_STAMP();
        if (!has_next) break;
#pragma unroll
        for (int a = 0; a < 2; ++a)
#pragma unroll
            for (int b = 0; b < 2; ++b)
#pragma unroll
                for (int m = 0; m < 4; ++m)
#pragma unroll
                    for (int n = 0; n < 2; ++n) acc[a][b][m][n] = (f32x4){0.f, 0.f, 0.f, 0.f};
        cur = nxt; cA = nA; cB = nB; ++ui;
    }
    PG8_WAIT_V(0);
    if (wr == 0) PG8_BAR;
    PG8_BAR;
    if constexpr (Epi::AFTER_DRAIN) { E.fused(acc, cur, wr, wc, fr, fq, lds, wid, lane); S.done(cur); }
    PG8_STAMP();
    if (STAMP && wid == 0) { stamps[lane] = lane < nts ? (((unsigned long long)(unsigned)ts_hi << 32) | (unsigned)ts_lo) : 0ull;
        if (lane == 62) stamps[62] = rt_entry; if (lane == 63) stamps[63] = (unsigned long long)wall_clock64(); }
#undef PG8_STAMP
#undef PG8_SA
#undef PG8_SB
#undef PG8_STAGE
#undef PG8_LDA
#undef PG8_LDB
#undef PG8_MMA
#undef PG8_WAIT_V
#undef PG8_WAIT_L
#undef PG8_BAR
#undef PG8_SCHED
}
}
#define XB_TMO      128
#define XB_XCNT(j)  (256  + 64 * (j))
#define XB_XSUB(j)  (1280 + 64 * (j))
#define XB_XGEN(j)  (2304 + 64 * (j))
#define XB_TOP      3328
#define XB_TOPGEN   3392
#define XCD_BAR_WORDS 3456
#define XB_SPIN_CAP (1u << 18)

__device__ __forceinline__ unsigned xb_ld(unsigned* p)              { return __hip_atomic_load(p, __ATOMIC_RELAXED, __HIP_MEMORY_SCOPE_AGENT); }
__device__ __forceinline__ unsigned xb_add(unsigned* p, unsigned v) { return __hip_atomic_fetch_add(p, v, __ATOMIC_RELAXED, __HIP_MEMORY_SCOPE_AGENT); }
__device__ __forceinline__ unsigned xb_xcc_id() { return (unsigned)__builtin_amdgcn_s_getreg((3 << 11) | 20) & 0xFu; }
#define XB_SPIN(cond, bar) do { unsigned _sp = 0; while (cond) { __builtin_amdgcn_s_sleep(1); \
    if ((++_sp & 255u) == 0u) { if (xb_ld(&(bar)[XB_TMO])) break; if (_sp > XB_SPIN_CAP) { atomicAdd(&(bar)[XB_TMO], 1u); break; } } } } while (0)

struct XcdBarrier {
    unsigned* bar; unsigned x;
    volatile LAS unsigned* st;
};

__device__ __forceinline__ XcdBarrier xcd_barrier_post(unsigned* bar, volatile LAS unsigned* st) {
    XcdBarrier b; b.bar = bar; b.x = xb_xcc_id(); b.st = st;
    if (threadIdx.x == 0) (void)xb_add(&bar[XB_XCNT(b.x)], 1u);
    return b;
}
__device__ __forceinline__ void xcd_barrier_complete(unsigned* bar, unsigned x, unsigned& nloc, unsigned& nx) {
    const unsigned G = gridDim.x * gridDim.y * gridDim.z;
    unsigned sum, cnt, mine, sp = 0u;
    for (;;) {
        sum = 0u; cnt = 0u; mine = 0u;
#pragma unroll
        for (unsigned j = 0; j < 16; ++j) { const unsigned c = xb_ld(&bar[XB_XCNT(j)]); sum += c; cnt += (c > 0u) ? 1u : 0u; mine = (j == x) ? c : mine; }
        if (sum == G) break;
        __builtin_amdgcn_s_sleep(1);
        if ((++sp & 255u) == 0u) { if (xb_ld(&bar[XB_TMO])) break; if (sp > XB_SPIN_CAP) { atomicAdd(&bar[XB_TMO], 1u); break; } }
    }
    nloc = mine > 0u ? mine : 1u; nx = cnt > 0u ? cnt : 1u;
}

__device__ __forceinline__ void xcd_barrier(const XcdBarrier& b) {
    asm volatile("s_waitcnt vmcnt(0)" ::: "memory");
    __syncthreads();
    if (threadIdx.x == 0) {
        unsigned* bar = b.bar;
        __builtin_amdgcn_s_waitcnt(0);
        unsigned nloc = b.st[0], nx = b.st[1];
        if (nloc == 0u) { xcd_barrier_complete(bar, b.x, nloc, nx); b.st[0] = nloc; b.st[1] = nx; }
        const unsigned old = xb_add(&bar[XB_XSUB(b.x)], 1u);
        const unsigned gen = old / nloc;
        if (old + 1u == (gen + 1u) * nloc) {
            __builtin_amdgcn_fence(__ATOMIC_RELEASE, "agent");
            asm volatile("s_waitcnt vmcnt(0)" ::: "memory");
            const unsigned og = xb_add(&bar[XB_TOP], 1u);
            const unsigned tg = og / nx;
            if (og + 1u == (tg + 1u) * nx) xb_add(&bar[XB_TOPGEN], 1u);
            else XB_SPIN(xb_ld(&bar[XB_TOPGEN]) == tg, bar);
            __builtin_amdgcn_fence(__ATOMIC_ACQUIRE, "agent");
            xb_add(&bar[XB_XGEN(b.x)], 1u);
            asm volatile("s_waitcnt vmcnt(0)" ::: "memory");
        } else {
            XB_SPIN(xb_ld(&bar[XB_XGEN(b.x)]) == gen, bar);
            __builtin_amdgcn_fence(__ATOMIC_ACQUIRE, "agent");
            asm volatile("s_waitcnt vmcnt(0)" ::: "memory");
        }
    }
    __syncthreads();
}


using pg8::bf16_t; using pg8::bf16x8; using pg8::f32x4; using pg8::u32x4; using pg8::cvt_pk_bf16;
typedef short bf16x4 __attribute__((ext_vector_type(4)));
typedef unsigned u32x2 __attribute__((ext_vector_type(2)));
constexpr int DM = 1024, TP = 16384, SB = 128, MT = TP + SB, SEQ = 2048, NBATCH = 8, NW = 7168, NZ = 4096, NIN = 7184, NADA = 136;
constexpr int ZQ = 0, ZK = 512, ZV = 1024, ZG = 0, ZZ = 1024, ZCG = 1536, ZMG = 2048, ZMC = 3072, ZSW = 4096;
constexpr float QSCALE = 0.08838834764831845f, ALPHA = 1.4142135623730951f, EPS = 1e-5f;
constexpr int NTHR = 512, LDS_BYTES = 147456;
constexpr size_t SZ_WIN = (size_t)NW * 1024 * 2, SZ_WPA = 1024 * 1024 * 2, SZ_WPB = 1024 * 512 * 2, SZ_WO = 1024 * 1024 * 2;
constexpr size_t OFF_CTL = 0, SZ_CTL = 65536;
constexpr size_t OFF_WIN = OFF_CTL + SZ_CTL, OFF_WPA = OFF_WIN + 2 * SZ_WIN, OFF_WPB = OFF_WPA + 2 * SZ_WPA, OFF_WO = OFF_WPB + 2 * SZ_WPB;
constexpr size_t OFF_ADA = OFF_WO + 2 * SZ_WO, SZ_ADA = (size_t)2 * NADA * 3072 * 4;
constexpr size_t OFF_U = OFF_ADA + SZ_ADA, SZ_U = (size_t)MT * 1024 * 2;
constexpr size_t OFF_Z = OFF_U + SZ_U, SZ_Z = (size_t)MT * NZ * 2;
constexpr size_t OFF_KST = OFF_Z + SZ_Z, SZ_KST = (size_t)MT * 512 * 2;
constexpr size_t OFF_B = OFF_KST + SZ_KST, SZ_B = (size_t)MT * 512 * 4;
constexpr size_t OFF_OG = OFF_B + SZ_B, SZ_OG = (size_t)MT * 1024 * 2;
constexpr size_t OFF_YC = OFF_OG + SZ_OG, SZ_YC = (size_t)MT * 512 * 2;
constexpr size_t OFF_Y1 = OFF_YC + SZ_YC, SZ_Y1 = (size_t)MT * 1024 * 4;
constexpr size_t OFF_VT = OFF_Y1 + SZ_Y1, SZ_VT = (size_t)TP * 1024 * 2;
constexpr size_t OFF_QF = OFF_VT + SZ_VT, SZ_QF = (size_t)TP * 512 * 2;
constexpr size_t OFF_KF = OFF_QF + SZ_QF, OFF_ZS = OFF_KF + SZ_QF, SZ_ZS = (size_t)SB * ZSW * 2;
constexpr size_t WS_END = OFF_ZS + SZ_ZS;
constexpr size_t OUT_Y = 0, OUT_GP = (size_t)MT * 1024, OUT_CP = OUT_GP + (size_t)2 * 8 * 4 * 128 * 256, OUT_GS = OUT_CP + 2 * 8 * 2 * 512, OUT_CS = OUT_GS + (size_t)2 * 128 * 4 * 128 * 256, OUT_END = OUT_CS + 2 * 128 * 2 * 512;

struct P {
    const float *xp, *xs, *cp, *cs, *sgla, *sconv, *w_ada, *b_ada, *w_in, *w_a2, *b_a, *gng, *conv_w, *w_pa, *w_pb, *w_o, *ln_g, *ln_b;
    float* out; unsigned char* ws; int ph_lo, ph_hi;
};
#define DI __device__ __forceinline__
DI bf16_t* wsb(const P& p, size_t off) { return (bf16_t*)(p.ws + off); }
DI float* wsf(const P& p, size_t off) { return (float*)(p.ws + off); }
DI float bf2f(unsigned short b) { return __uint_as_float(((unsigned)b) << 16); }
DI float bflo(unsigned w) { return __uint_as_float(w << 16); }
DI float bfhi(unsigned w) { return __uint_as_float(w & 0xffff0000u); }
DI unsigned short f2bf(float f) { return (unsigned short)(cvt_pk_bf16(f, 0.f) & 0xffffu); }
DI float sigmoidf_(float x) { return __builtin_amdgcn_rcpf(1.0f + __expf(-x)); }
DI float siluf_(float x) { return x * sigmoidf_(x); }
DI const float* xrow(const P& p, int l, int r) { return l == 0 ? (r < TP ? p.xp + (size_t)r * 1024 : p.xs + (size_t)(r - TP) * 1024) : wsf(p, OFF_Y1) + (size_t)r * 1024; }
DI int ada_row(int r) { return r < TP ? (r >> 11) : NBATCH + (r - TP); }
DI f32x4 mfma16(bf16x8 a, bf16x8 b, f32x4 c) { return __builtin_amdgcn_mfma_f32_16x16x32_bf16(a, b, c, 0, 0, 0); }
DI float wave_sum(float v) {
#pragma unroll
    for (int o = 32; o >= 1; o >>= 1) v += __shfl_xor(v, o);
    return v;
}

struct P0Tile { const float* src; bf16_t* dst; int ld, ldd; };
DI P0Tile p0_tile(const P& p, int t) {
    P0Tile r; const int l = t / 2432; int u = t % 2432;
    if (u < 1792) { const int kt = u & 15, n0 = (u >> 4) * 64; int sc = n0 < 3072 ? n0 : n0 + 16;
        if (n0 < 1024) { const int hd = n0 >> 8, o = n0 & 255; sc = (o >> 7) * 512 + hd * 128 + (o & 127); }
        if (n0 >= 3072 && n0 < 5120) { const int T = n0 >> 8, o = n0 & 255, hf = o >> 7, oo = o & 127, i = (T - 12) & 3, comp = T < 16 ? (hf ? 2 : 1) : (hf ? 3 : 0);
            sc = 3088 + comp * 512 + 128 * i + oo; }
        r.src = p.w_in + (size_t)l * 1024 * NIN + (size_t)(kt * 64) * NIN + sc; r.ld = NIN; r.dst = wsb(p, OFF_WIN + l * SZ_WIN) + (size_t)n0 * 1024 + kt * 64; r.ldd = 1024; }
    else if (u < 2048) { u -= 1792; const int kt = u & 15, n0 = (u >> 4) * 64;
        r.src = p.w_pa + (size_t)l * 1024 * 1024 + (size_t)(kt * 64) * 1024 + n0; r.ld = 1024; r.dst = wsb(p, OFF_WPA + l * SZ_WPA) + (size_t)n0 * 1024 + kt * 64; r.ldd = 1024; }
    else if (u < 2176) { u -= 2048; const int kt = u & 7, n0 = (u >> 3) * 64;
        r.src = p.w_pb + (size_t)l * 512 * 1024 + (size_t)(kt * 64) * 1024 + n0; r.ld = 1024; r.dst = wsb(p, OFF_WPB + l * SZ_WPB) + (size_t)n0 * 512 + kt * 64; r.ldd = 512; }
    else { u -= 2176; const int kt = u & 15, n0 = (u >> 4) * 64;
        r.src = p.w_o + (size_t)l * 1024 * 1024 + (size_t)(kt * 64) * 1024 + n0; r.ld = 1024; r.dst = wsb(p, OFF_WO + l * SZ_WO) + (size_t)n0 * 1024 + kt * 64; r.ldd = 1024; }
    return r;
}
__device__ __forceinline__ void phase0(const P& p, unsigned char* sm) {
    const int tid = threadIdx.x + opaque_zero();
    {   const int w = tid >> 6, lane = tid & 63, fr = lane & 15, fq = lane >> 4;
        for (int t = (int)blockIdx.x * 8 + w; t < 9 * 192; t += (int)gridDim.x * 8) {
            const int ct = t / 9, rt = t - ct * 9, l = ct / 96, n0 = (ct - l * 96) * 32;
            const int row = rt * 16 + fr < NADA ? rt * 16 + fr : NADA - 1;
            const float* crow = (row < NBATCH ? p.cp + (size_t)row * 1024 : p.cs + (size_t)(row - NBATCH) * 1024) + 4 * fq;
            const float* wb = p.w_ada + (size_t)l * 1024 * 3072 + (size_t)(4 * fq) * 3072 + n0 + fr;
            f32x4 a0 = {0.f, 0.f, 0.f, 0.f}, a1 = {0.f, 0.f, 0.f, 0.f};
#pragma unroll 8
            for (int k0 = 0; k0 < 1024; k0 += 16) {
                const f32x4 av = *(const f32x4*)(crow + k0);
#pragma unroll
                for (int j = 0; j < 4; ++j) { const float b0 = wb[(size_t)(k0 + j) * 3072], b1 = wb[(size_t)(k0 + j) * 3072 + 16];
                    a0 = __builtin_amdgcn_mfma_f32_16x16x4f32(av[j], b0, a0, 0, 0, 0); a1 = __builtin_amdgcn_mfma_f32_16x16x4f32(av[j], b1, a1, 0, 0, 0); }
            }
            const float bb0 = p.b_ada[l * 3072 + n0 + fr], bb1 = p.b_ada[l * 3072 + n0 + 16 + fr];
#pragma unroll
            for (int e = 0; e < 4; ++e) { const int ro = rt * 16 + 4 * fq + e; if (ro < NADA) { float* d = wsf(p, OFF_ADA) + ((size_t)l * NADA + ro) * 3072 + n0 + fr; d[0] = a0[e] + bb0; d[16] = a1[e] + bb1; } }
        }
    }
}
__device__ __forceinline__ void p0_convert(const P& p, unsigned char* sm) {
    const int tid = threadIdx.x + opaque_zero();
    __syncthreads();
    {   float* Ts = (float*)sm;
        const int nb = (int)gridDim.x, vb = (int)blockIdx.x;
        for (int t0 = vb; t0 < 2 * 2432; t0 += 4 * nb) {
            float4 rv0[4], rv1[4]; bf16_t* tdst[4]; int tldd[4];
            const int kk = tid >> 4, n4 = (tid & 15) * 4;
#pragma unroll
            for (int q = 0; q < 4; ++q) { const int t = t0 + q * nb; const P0Tile tl = p0_tile(p, t < 2 * 2432 ? t : 2 * 2432 - 1); tdst[q] = tl.dst; tldd[q] = tl.ldd;
                rv0[q] = *(const float4*)(tl.src + (size_t)kk * tl.ld + n4); rv1[q] = *(const float4*)(tl.src + (size_t)(kk + 32) * tl.ld + n4); }
#pragma unroll
            for (int q = 0; q < 4; ++q) { float* T = Ts + q * 4160;
                { const float4 v = rv0[q]; T[kk * 65 + n4] = v.x; T[kk * 65 + n4 + 1] = v.y; T[kk * 65 + n4 + 2] = v.z; T[kk * 65 + n4 + 3] = v.w; }
                { const float4 v = rv1[q]; T[(kk + 32) * 65 + n4] = v.x; T[(kk + 32) * 65 + n4 + 1] = v.y; T[(kk + 32) * 65 + n4 + 2] = v.z; T[(kk + 32) * 65 + n4 + 3] = v.w; } }
            __syncthreads();
#pragma unroll
            for (int q = 0; q < 4; ++q) { const int t = t0 + q * nb; const float* T = Ts + q * 4160; const int n = tid >> 3, k8 = (tid & 7) * 8; u32x4 w;
                w.x = cvt_pk_bf16(T[(k8 + 0) * 65 + n], T[(k8 + 1) * 65 + n]); w.y = cvt_pk_bf16(T[(k8 + 2) * 65 + n], T[(k8 + 3) * 65 + n]);
                w.z = cvt_pk_bf16(T[(k8 + 4) * 65 + n], T[(k8 + 5) * 65 + n]); w.w = cvt_pk_bf16(T[(k8 + 6) * 65 + n], T[(k8 + 7) * 65 + n]);
                if (t < 2 * 2432) *(u32x4*)(tdst[q] + (size_t)n * tldd[q] + k8) = w; }
            __syncthreads();
        }
    }
}

DI void p1_row(const P& p, int mode, int r, float4 (&xv)[4], const float4 (&sh)[4], const float4 (&sc)[4], const float* lg_p, const float* lb_p, float* ydst, const float* WaT, float* alr, int lane) {
    if (mode != 0) {
        const float* lnp = (const float*)lg_p + opaque_zero();
        float4 lg[4], lb[4];
#pragma unroll
        for (int q = 0; q < 4; ++q) { lg[q] = *(const float4*)(lnp + 256 * q + 4 * lane); lb[q] = *(const float4*)(lnp + (lb_p - lg_p) + 256 * q + 4 * lane); }
        float s = 0.f;
#pragma unroll
        for (int q = 0; q < 4; ++q) s += xv[q].x + xv[q].y + xv[q].z + xv[q].w;
        const float mean = wave_sum(s) * (1.0f / 1024.0f);
        float vs = 0.f;
#pragma unroll
        for (int q = 0; q < 4; ++q) { xv[q].x -= mean; xv[q].y -= mean; xv[q].z -= mean; xv[q].w -= mean; vs += xv[q].x * xv[q].x + xv[q].y * xv[q].y + xv[q].z * xv[q].z + xv[q].w * xv[q].w; }
        const float rstd = rsqrtf(wave_sum(vs) * (1.0f / 1024.0f) + EPS);
#pragma unroll
        for (int q = 0; q < 4; ++q) {
            xv[q].x = xv[q].x * rstd * lg[q].x + lb[q].x; xv[q].y = xv[q].y * rstd * lg[q].y + lb[q].y; xv[q].z = xv[q].z * rstd * lg[q].z + lb[q].z; xv[q].w = xv[q].w * rstd * lg[q].w + lb[q].w;
            if (mode == 1) { u32x2 pk; pk.x = cvt_pk_bf16(xv[q].x, xv[q].y); pk.y = cvt_pk_bf16(xv[q].z, xv[q].w); *(u32x2*)((bf16_t*)ydst + (size_t)r * 1024 + 256 * q + 4 * lane) = pk; }
            else *(float4*)(ydst + (size_t)r * 1024 + 256 * q + 4 * lane) = xv[q]; }
    }
    if (mode == 2) return;
    float pa[16];
#pragma unroll
    for (int j = 0; j < 16; ++j) pa[j] = 0.f;
#pragma unroll
    for (int q = 0; q < 4; ++q) { const int c = 256 * q + 4 * lane;
        float4 u; u.x = xv[q].x * (1.0f + sc[q].x) + sh[q].x; u.y = xv[q].y * (1.0f + sc[q].y) + sh[q].y; u.z = xv[q].z * (1.0f + sc[q].z) + sh[q].z; u.w = xv[q].w * (1.0f + sc[q].w) + sh[q].w;
        u32x2 pk; pk.x = cvt_pk_bf16(u.x, u.y); pk.y = cvt_pk_bf16(u.z, u.w);
        *(u32x2*)(wsb(p, OFF_U) + (size_t)r * 1024 + c) = pk;
#pragma unroll
        for (int j = 0; j < 16; ++j) { const float4 wv = *(const float4*)(WaT + j * 1024 + c); pa[j] = fmaf(u.x, wv.x, fmaf(u.y, wv.y, fmaf(u.z, wv.z, fmaf(u.w, wv.w, pa[j])))); } }
    float p8[8], p4[4], p2[2], p1;
    { const bool b = lane & 32;
#pragma unroll
      for (int j = 0; j < 8; ++j) { const float keep = b ? pa[j + 8] : pa[j], send = b ? pa[j] : pa[j + 8]; p8[j] = keep + __shfl_xor(send, 32); } }
    { const bool b = lane & 16;
#pragma unroll
      for (int j = 0; j < 4; ++j) { const float keep = b ? p8[j + 4] : p8[j], send = b ? p8[j] : p8[j + 4]; p4[j] = keep + __shfl_xor(send, 16); } }
    { const bool b = lane & 8;
#pragma unroll
      for (int j = 0; j < 2; ++j) { const float keep = b ? p4[j + 2] : p4[j], send = b ? p4[j] : p4[j + 2]; p2[j] = keep + __shfl_xor(send, 8); } }
    { const bool b = lane & 4; const float keep = b ? p2[1] : p2[0], send = b ? p2[0] : p2[1]; p1 = keep + __shfl_xor(send, 4); }
    p1 += __shfl_xor(p1, 1); p1 += __shfl_xor(p1, 2);
    if ((lane & 3) == 0) { const int r16 = 8 * ((lane >> 5) & 1) + 4 * ((lane >> 4) & 1) + 2 * ((lane >> 3) & 1) + ((lane >> 2) & 1); alr[r16] = p1; }
}
__device__ __forceinline__ void phase1(const P& p, unsigned char* sm, int l, int mode) {
    const int tid = threadIdx.x + opaque_zero(), w = tid >> 6, lane = tid & 63;
    float* WaT = (float*)sm;
    float* ALR = (float*)(sm + 65536);
    if (mode != 2) {
        const float* wsrc = p.w_in + (size_t)l * 1024 * NIN + 3072;
#pragma unroll 8
        for (int e = tid; e < 16384; e += NTHR) { const int k = e >> 4, r = e & 15; WaT[r * 1024 + k] = wsrc[(size_t)k * NIN + r]; }
    }
    const bf16_t* GO = wsb(p, OFF_Z);
    const float* xprev = (mode == 1) ? p.xp : wsf(p, OFF_Y1);
    const int lnl = (mode == 1) ? l - 1 : l;
    float* ydst = (mode == 1) ? wsf(p, OFF_Y1) : p.out + OUT_Y;
    const float* lg = p.ln_g + lnl * 1024; const float* lb = p.ln_b + lnl * 1024;
    __syncthreads();
    for (int it = blockIdx.x; it < TP / 64; it += gridDim.x) {
        const float* ada = wsf(p, OFF_ADA) + ((size_t)l * NADA + (it >> 5)) * 3072;
        float4 sh[4], sc[4];
#pragma unroll
        for (int q = 0; q < 4; ++q) { sh[q] = (float4){0.f, 0.f, 0.f, 0.f}; sc[q] = sh[q]; }
        if (mode != 2) {
#pragma unroll
            for (int q = 0; q < 4; ++q) { sh[q] = *(const float4*)(ada + 256 * q + 4 * lane); sc[q] = *(const float4*)(ada + 1024 + 256 * q + 4 * lane); } }
#pragma unroll 1
        for (int g = 0; g < 2; ++g) {
            float4 xv[4][4]; u32x2 gv[4][4];
#pragma unroll
            for (int rr = 0; rr < 4; ++rr) { const int r = it * 64 + w * 8 + g * 4 + rr; const float* src = (mode == 0) ? p.xp + (size_t)r * 1024 : xprev + (size_t)r * 1024;
#pragma unroll
                for (int q = 0; q < 4; ++q) {
                    if (mode == 2) { const u32x2 yb = *(const u32x2*)((const bf16_t*)xprev + (size_t)r * 1024 + 256 * q + 4 * lane); xv[rr][q] = (float4){bflo(yb.x), bfhi(yb.x), bflo(yb.y), bfhi(yb.y)}; }
                    else xv[rr][q] = *(const float4*)(src + 256 * q + 4 * lane);
                    if (mode != 0) gv[rr][q] = *(const u32x2*)(GO + (size_t)r * 1024 + 256 * q + 4 * lane); } }
#pragma unroll
            for (int rr = 0; rr < 4; ++rr) { const int i = w * 8 + g * 4 + rr;
                if (mode != 0) {
#pragma unroll
                    for (int q = 0; q < 4; ++q) { const u32x2 gq = gv[rr][q]; xv[rr][q].x = ALPHA * xv[rr][q].x + bflo(gq.x); xv[rr][q].y = ALPHA * xv[rr][q].y + bfhi(gq.x); xv[rr][q].z = ALPHA * xv[rr][q].z + bflo(gq.y); xv[rr][q].w = ALPHA * xv[rr][q].w + bfhi(gq.y); } }
                p1_row(p, mode, it * 64 + i, xv[rr], sh, sc, lg, lb, ydst, WaT, ALR + i * 16, lane); }
        }
        const bool has_s = it < SB;
        if (has_s && w == 0) {
            const int r = TP + it; const float* src = (mode == 2) ? xprev + (size_t)r * 1024 : p.xs + (size_t)it * 1024;
            const float* ada_s = wsf(p, OFF_ADA) + ((size_t)l * NADA + NBATCH + it) * 3072;
            float4 xs[4], sh2[4], sc2[4];
#pragma unroll
            for (int q = 0; q < 4; ++q) { sh2[q] = sh[q]; sc2[q] = sc[q];
                if (mode == 2) { const u32x2 yb = *(const u32x2*)((const bf16_t*)xprev + (size_t)r * 1024 + 256 * q + 4 * lane); xs[q] = (float4){bflo(yb.x), bfhi(yb.x), bflo(yb.y), bfhi(yb.y)}; }
                else xs[q] = *(const float4*)(src + 256 * q + 4 * lane);
                if (mode != 0) { const u32x2 gq = *(const u32x2*)(GO + (size_t)r * 1024 + 256 * q + 4 * lane);
                    xs[q].x = ALPHA * xs[q].x + bflo(gq.x); xs[q].y = ALPHA * xs[q].y + bfhi(gq.x); xs[q].z = ALPHA * xs[q].z + bflo(gq.y); xs[q].w = ALPHA * xs[q].w + bfhi(gq.y); } }
            if (mode != 2) {
#pragma unroll
                for (int q = 0; q < 4; ++q) { sh2[q] = *(const float4*)(ada_s + 256 * q + 4 * lane); sc2[q] = *(const float4*)(ada_s + 1024 + 256 * q + 4 * lane); } }
            p1_row(p, mode, r, xs, sh2, sc2, lg, lb, ydst, WaT, ALR + 64 * 16, lane);
        }
        if (mode == 2) continue;
        __syncthreads();
        {
            float w2[16];
#pragma unroll
            for (int j = 0; j < 16; ++j) w2[j] = p.w_a2[((size_t)l * 16 + j) * 512 + tid];
            const float ba = p.b_a[l * 512 + tid];
            float run = 0.f; float* Bc = wsf(p, OFF_B) + (size_t)it * 64 * 512 + tid;
#pragma unroll 4
            for (int i = 0; i < 64; ++i) {
                float x = ba;
#pragma unroll
                for (int j4 = 0; j4 < 4; ++j4) { const float4 a = *(const float4*)(ALR + i * 16 + 4 * j4); x = fmaf(a.x, w2[4 * j4], fmaf(a.y, w2[4 * j4 + 1], fmaf(a.z, w2[4 * j4 + 2], fmaf(a.w, w2[4 * j4 + 3], x)))); }
                run += (fminf(x, 0.f) - __logf(1.0f + __expf(-fabsf(x)))) * (1.0f / 16.0f);
                Bc[(size_t)i * 512] = run;
            }
            if (has_s) { float x = ba;
#pragma unroll
                for (int j4 = 0; j4 < 4; ++j4) { const float4 a = *(const float4*)(ALR + 64 * 16 + 4 * j4); x = fmaf(a.x, w2[4 * j4], fmaf(a.y, w2[4 * j4 + 1], fmaf(a.z, w2[4 * j4 + 2], fmaf(a.w, w2[4 * j4 + 3], x)))); }
                wsf(p, OFF_B)[(size_t)(TP + it) * 512 + tid] = (fminf(x, 0.f) - __logf(1.0f + __expf(-fabsf(x)))) * (1.0f / 16.0f); }
        }
        __syncthreads();
    }
}

DI void in_elem(const P& p, int r, int c, float v) {
    bf16_t* Z = wsb(p, OFF_Z); const float* Bc = wsf(p, OFF_B);
    bf16_t* ZS = wsb(p, OFF_ZS) + (size_t)(r - TP) * ZSW;
    if (c < 1024) { const int hd = c >> 8, o = c & 255, cc = hd * 128 + (o & 127); const float b = Bc[(size_t)r * 512 + cc];
        if (o < 128) ZS[ZQ + cc] = f2bf(v * QSCALE * __expf(b));
        else { ZS[ZK + cc] = f2bf(v * __expf(-b)); wsb(p, OFF_KST)[(size_t)r * 512 + cc] = f2bf(v); } }
    else if (c < 2048) ZS[c] = f2bf(v);
    else if (c < 3072) Z[(size_t)r * NZ + c - 2048] = f2bf(v);
    else if (c < 5120) { const int T = c >> 8, o = c & 255, hf = o >> 7, oo = o & 127, i = (T - 12) & 3, comp = T < 16 ? (hf ? 1 : 0) : (hf ? 3 : 2);
        ZS[2048 + comp * 512 + 128 * i + oo] = f2bf(v); }
    else Z[(size_t)r * NZ + c - 3072] = f2bf(v);
}
DI u32x4 wave_transpose_16x32(LAS unsigned char* T, int fr, int fq, const float (&v)[8]) {
    const int wo = (8 * fq * 16 + fr) * 2 + fq * 16;
#pragma unroll
    for (int e = 0; e < 8; ++e) *(LAS bf16_t*)(T + wo + e * 32) = f2bf(v[e]);
    const int lane = fq * 16 + fr, col = lane >> 1, half = lane & 1;
    return *(const LAS u32x4*)(T + (col * 16 + half * 8) * 2 + (col >> 3) * 16);
}
struct EpiIn {
    static constexpr bool PERM = true, AFTER_DRAIN = false;
    bf16_t* Z; bf16_t* KST; bf16_t* VT; bf16_t* QF; bf16_t* KF; const float* Bc; LAS unsigned char* tsc;
    __device__ __forceinline__ void operator()(const f32x4 (&acc)[2][2][4][2], const pg8::Unit& u, int wr, int wc, int fr, int fq) const {
        const int row0 = u.pm * 256 + wr * 64 + fr + opaque_zero(), colt = u.pn * 256, col0 = colt + wc * 32 + 8 * fq;
        const int lane_ = fq * 16 + fr;
        if (colt < 1024) {
            const int hd = colt >> 8, ch0 = wc * 32 + 8 * fq;
#pragma unroll
            for (int ai = 0; ai < 2; ++ai)
#pragma unroll
                for (int mh = 0; mh < 2; ++mh) {
                    f32x4 bb[2][2], ll[2][2];
#pragma unroll
                    for (int mm = 0; mm < 2; ++mm) { const int r = row0 + ai * 128 + (mh * 2 + mm) * 16;
                        const float* bp = Bc + (size_t)r * 512 + hd * 128 + ch0; const float* lp = Bc + (size_t)(r | 63) * 512 + hd * 128 + ch0;
                        bb[mm][0] = *(const f32x4*)bp; bb[mm][1] = *(const f32x4*)(bp + 4); ll[mm][0] = *(const f32x4*)lp; ll[mm][1] = *(const f32x4*)(lp + 4); }
#pragma unroll
                    for (int mm = 0; mm < 2; ++mm) { const int m = mh * 2 + mm, r = row0 + ai * 128 + m * 16;
                        const f32x4 q0 = acc[ai][0][m][0], q1 = acc[ai][0][m][1], k0 = acc[ai][1][m][0], k1 = acc[ai][1][m][1], b0 = bb[mm][0], b1 = bb[mm][1], l0 = ll[mm][0], l1 = ll[mm][1];
                        const size_t ubase = (size_t)(((r >> 11) * 4 + hd) * 32 + ((r >> 6) & 31)) * 8192; const int foff = ((((r >> 4) & 3) * 4 + wc) * 64 + fq * 16 + (r & 15)) * 8;
                        float e0[4], e1[4];
#pragma unroll
                        for (int j = 0; j < 4; ++j) { e0[j] = __expf(b0[j]); e1[j] = __expf(b1[j]); }
                        {   u32x4 w; w.x = cvt_pk_bf16(q0[0] * QSCALE * e0[0], q0[1] * QSCALE * e0[1]); w.y = cvt_pk_bf16(q0[2] * QSCALE * e0[2], q0[3] * QSCALE * e0[3]);
                            w.z = cvt_pk_bf16(q1[0] * QSCALE * e1[0], q1[1] * QSCALE * e1[1]); w.w = cvt_pk_bf16(q1[2] * QSCALE * e1[2], q1[3] * QSCALE * e1[3]);
                            *(u32x4*)(QF + ubase + foff) = w; }
                        float kv[8];
#pragma unroll
                        for (int j = 0; j < 4; ++j) { kv[j] = k0[j] * __expf(l0[j] - b0[j]); kv[j + 4] = k1[j] * __expf(l1[j] - b1[j]); }
                        const u32x4 tv = wave_transpose_16x32(tsc + (wr * 4 + wc) * 1152, fr, fq, kv);
                        const int kk_ = wc * 32 + (lane_ >> 1), rf = r - fr, jb_ = ((rf & 63) >> 3) + (lane_ & 1);
                        *(u32x4*)(KST + ubase + ((((kk_ >> 4) * 2 + (jb_ >> 2)) * 64 + (jb_ & 3) * 16 + (kk_ & 15)) * 8)) = tv;
                        {   u32x4 w; w.x = cvt_pk_bf16(k0[0] * __expf(-b0[0]), k0[1] * __expf(-b0[1])); w.y = cvt_pk_bf16(k0[2] * __expf(-b0[2]), k0[3] * __expf(-b0[3]));
                            w.z = cvt_pk_bf16(k1[0] * __expf(-b1[0]), k1[1] * __expf(-b1[1])); w.w = cvt_pk_bf16(k1[2] * __expf(-b1[2]), k1[3] * __expf(-b1[3]));
                            *(u32x4*)(KF + ubase + foff) = w; } }
                    __builtin_amdgcn_sched_barrier(0);
                }
        } else if (colt < 2048) {
#pragma unroll
            for (int ai = 0; ai < 2; ++ai)
#pragma unroll
                for (int m = 0; m < 4; ++m)
#pragma unroll
                    for (int bj = 0; bj < 2; ++bj) { const int r = row0 + ai * 128 + m * 16; const f32x4 v0 = acc[ai][bj][m][0], v1 = acc[ai][bj][m][1];
                        float vv[8];
#pragma unroll
                        for (int j = 0; j < 4; ++j) { vv[j] = v0[j]; vv[j + 4] = v1[j]; }
                        const u32x4 tv = wave_transpose_16x32(tsc + (wr * 4 + wc) * 1152, fr, fq, vv);
                        const int hv = colt - 1024 + bj * 128 + wc * 32 + (lane_ >> 1), rf = r - fr, vv_ = hv & 255, jb_ = ((rf & 63) >> 3) + (lane_ & 1);
                        *(u32x4*)(VT + (size_t)(((rf >> 11) * 4 + (hv >> 8)) * 32 + ((rf >> 6) & 31)) * 16384 + ((((vv_ >> 4) * 2 + (jb_ >> 2)) * 64 + (jb_ & 3) * 16 + (vv_ & 15)) * 8)) = tv; }
        } else if (colt >= 3072 && colt < 5120) {
            const bool zt = colt < 4096; const int cz = (zt ? ZZ : ZCG) + (((colt - 3072) >> 8) & 3) * 128 + wc * 32 + 8 * fq;
#pragma unroll
            for (int ai = 0; ai < 2; ++ai)
#pragma unroll
                for (int m = 0; m < 4; ++m) { const f32x4 a0 = acc[ai][0][m][0], a1 = acc[ai][0][m][1], b0 = acc[ai][1][m][0], b1 = acc[ai][1][m][1];
                    float o[8];
#pragma unroll
                    for (int j = 0; j < 4; ++j) { o[j] = a0[j] * (zt ? b0[j] : siluf_(b0[j])); o[j + 4] = a1[j] * (zt ? b1[j] : siluf_(b1[j])); }
                    u32x4 w; w.x = cvt_pk_bf16(o[0], o[1]); w.y = cvt_pk_bf16(o[2], o[3]); w.z = cvt_pk_bf16(o[4], o[5]); w.w = cvt_pk_bf16(o[6], o[7]);
                    __builtin_nontemporal_store(w, (u32x4*)(Z + (size_t)(row0 + ai * 128 + m * 16) * NZ + cz)); }
        } else {
            const int cs = colt < 3072 ? 2048 : 3072;
#pragma unroll
            for (int ai = 0; ai < 2; ++ai)
#pragma unroll
                for (int m = 0; m < 4; ++m)
#pragma unroll
                    for (int bj = 0; bj < 2; ++bj) { const f32x4 v0 = acc[ai][bj][m][0], v1 = acc[ai][bj][m][1];
                        u32x4 w; w.x = cvt_pk_bf16(v0[0], v0[1]); w.y = cvt_pk_bf16(v0[2], v0[3]); w.z = cvt_pk_bf16(v1[0], v1[1]); w.w = cvt_pk_bf16(v1[2], v1[3]);
                        __builtin_nontemporal_store(w, (u32x4*)(Z + (size_t)(row0 + ai * 128 + m * 16) * NZ + col0 - cs + bj * 128)); }
        }
    }
};
template <int SECOND> struct EpiMerge {
    static constexpr bool PERM = true, AFTER_DRAIN = false;
    bf16_t* MG; const bf16_t* Z;
    __device__ __forceinline__ void operator()(const f32x4 (&acc)[2][2][4][2], const pg8::Unit& u, int wr, int wc, int fr, int fq) const {
        const int row0 = u.pm * 256 + wr * 64 + fr + opaque_zero(), col0 = u.pn * 256 + wc * 32 + 8 * fq;
#pragma unroll
        for (int ai = 0; ai < 2; ++ai) {
            u32x4 g[4][2], t[4][2];
#pragma unroll
            for (int m = 0; m < 4; ++m)
#pragma unroll
                for (int bj = 0; bj < 2; ++bj) { const size_t r = (size_t)(row0 + ai * 128 + m * 16); const int c = col0 + bj * 128;
                    g[m][bj] = *(const u32x4*)(Z + r * NZ + (SECOND ? ZMC : ZMG) + c);
                    if (SECOND) t[m][bj] = *(const u32x4*)(MG + r * 1024 + c); }
#pragma unroll
            for (int m = 0; m < 4; ++m)
#pragma unroll
                for (int bj = 0; bj < 2; ++bj) { const size_t r = (size_t)(row0 + ai * 128 + m * 16); const int c = col0 + bj * 128; const f32x4 v0 = acc[ai][bj][m][0], v1 = acc[ai][bj][m][1];
                    const u32x4 gg = g[m][bj]; float o[8];
                    o[0] = v0[0] * sigmoidf_(bflo(gg.x)); o[1] = v0[1] * sigmoidf_(bfhi(gg.x)); o[2] = v0[2] * sigmoidf_(bflo(gg.y)); o[3] = v0[3] * sigmoidf_(bfhi(gg.y));
                    o[4] = v1[0] * sigmoidf_(bflo(gg.z)); o[5] = v1[1] * sigmoidf_(bfhi(gg.z)); o[6] = v1[2] * sigmoidf_(bflo(gg.w)); o[7] = v1[3] * sigmoidf_(bfhi(gg.w));
                    if (SECOND) { const u32x4 tt = t[m][bj];
                        o[0] += bflo(tt.x); o[1] += bfhi(tt.x); o[2] += bflo(tt.y); o[3] += bfhi(tt.y); o[4] += bflo(tt.z); o[5] += bfhi(tt.z); o[6] += bflo(tt.w); o[7] += bfhi(tt.w); }
                    u32x4 w; w.x = cvt_pk_bf16(o[0], o[1]); w.y = cvt_pk_bf16(o[2], o[3]); w.z = cvt_pk_bf16(o[4], o[5]); w.w = cvt_pk_bf16(o[6], o[7]);
                    *(u32x4*)(MG + r * 1024 + c) = w; }
            __builtin_amdgcn_sched_barrier(0);
        }
    }
};
struct EpiGate {
    static constexpr bool PERM = true, AFTER_DRAIN = false;
    bf16_t* GO; const float* ada;
    __device__ __forceinline__ void operator()(const f32x4 (&acc)[2][2][4][2], const pg8::Unit& u, int wr, int wc, int fr, int fq) const {
        const int row0 = u.pm * 256 + wr * 64 + fr + opaque_zero(), col0 = u.pn * 256 + wc * 32 + 8 * fq;
        const float* gate = ada + (size_t)(u.pm >> 3) * 3072 + 2048 + col0;
        f32x4 gv[2][2];
#pragma unroll
        for (int bj = 0; bj < 2; ++bj) { gv[bj][0] = *(const f32x4*)(gate + bj * 128); gv[bj][1] = *(const f32x4*)(gate + bj * 128 + 4); }
#pragma unroll
        for (int ai = 0; ai < 2; ++ai)
#pragma unroll
            for (int m = 0; m < 4; ++m)
#pragma unroll
                for (int bj = 0; bj < 2; ++bj) { const f32x4 v0 = acc[ai][bj][m][0] * gv[bj][0], v1 = acc[ai][bj][m][1] * gv[bj][1];
                    u32x4 w; w.x = cvt_pk_bf16(v0[0], v0[1]); w.y = cvt_pk_bf16(v0[2], v0[3]); w.z = cvt_pk_bf16(v1[0], v1[1]); w.w = cvt_pk_bf16(v1[2], v1[3]);
                    *(u32x4*)(GO + (size_t)(row0 + ai * 128 + m * 16) * 1024 + col0 + bj * 128) = w; }
    }
};
DI f32x4 small_mma(const bf16_t* A, int lda, const bf16_t* Bt, int K, int arow0, int n0, int fr, int fq) {
    f32x4 acc = {0.f, 0.f, 0.f, 0.f};
    const bf16_t* ap = A + (size_t)(arow0 + fr) * lda + 8 * fq; const bf16_t* bp = Bt + (size_t)(n0 + fr) * K + 8 * fq;
#pragma unroll 16
    for (int k = 0; k < K; k += 32) acc = mfma16(*(const bf16x8*)(ap + k), *(const bf16x8*)(bp + k), acc);
    return acc;
}

__device__ __forceinline__ void phase2(const P& p, unsigned char* sm, int l) {
    {   pg8::Gemm g; g.A = wsb(p, OFF_U); g.Bt = wsb(p, OFF_WIN + l * SZ_WIN); g.M = TP; g.N = NW; g.K = 1024;
        pg8::StaticOrder S; S.init(TP, NW, (int)gridDim.x, (int)blockIdx.x);
        EpiIn E; E.Z = wsb(p, OFF_Z); E.KST = wsb(p, OFF_KST); E.VT = wsb(p, OFF_VT); E.QF = wsb(p, OFF_QF); E.KF = wsb(p, OFF_KF); E.Bc = wsf(p, OFF_B); E.tsc = (LAS unsigned char*)sm + 131072;
        pg8::gemm_phase<EpiIn, pg8::StaticOrder, false>((LAS unsigned char*)sm, g, S, E, nullptr); }
    const int tid = threadIdx.x + opaque_zero(), w = tid >> 6, lane = tid & 63, fr = lane & 15, fq = lane >> 4;
    for (int t = w * (int)gridDim.x + (int)blockIdx.x; t < (NW / 32) * 8; t += 8 * (int)gridDim.x) {
        const int ct = t >> 3, rt = t & 7;
        const bf16_t* ap = wsb(p, OFF_U) + (size_t)(TP + 16 * rt + fr) * 1024 + 8 * fq; const bf16_t* bp = wsb(p, OFF_WIN + l * SZ_WIN) + (size_t)(ct * 32 + fr) * 1024 + 8 * fq;
        f32x4 a0 = {0.f, 0.f, 0.f, 0.f}, a1 = {0.f, 0.f, 0.f, 0.f};
#pragma unroll 8
        for (int k = 0; k < 1024; k += 32) { const bf16x8 av = *(const bf16x8*)(ap + k); a0 = mfma16(av, *(const bf16x8*)(bp + k), a0); a1 = mfma16(av, *(const bf16x8*)(bp + 16 * 1024 + k), a1); }
#pragma unroll
        for (int j = 0; j < 4; ++j) { in_elem(p, TP + 16 * rt + 4 * fq + j, ct * 32 + fr, a0[j]); in_elem(p, TP + 16 * rt + 4 * fq + j, ct * 32 + 16 + fr, a1[j]); }
    }
}
__device__ __forceinline__ void phase4(const P& p, unsigned char* sm, int l) {
    bf16_t* MG = wsb(p, OFF_U);
    {   pg8::Gemm g; g.A = wsb(p, OFF_OG); g.Bt = wsb(p, OFF_WPA + l * SZ_WPA); g.M = TP; g.N = 1024; g.K = 1024;
        pg8::StaticOrder S; S.init(TP, 1024, (int)gridDim.x, (int)blockIdx.x);
        EpiMerge<0> E; E.MG = MG; E.Z = wsb(p, OFF_Z);
        pg8::gemm_phase<EpiMerge<0>, pg8::StaticOrder, false>((LAS unsigned char*)sm, g, S, E, nullptr); }
    asm volatile("s_waitcnt vmcnt(0)" ::: "memory"); __syncthreads();
    {   const int oz = opaque_zero(); pg8::Gemm g; g.A = wsb(p, OFF_YC) + oz; g.Bt = wsb(p, OFF_WPB + l * SZ_WPB) + oz; g.M = TP; g.N = 1024; g.K = 512 + oz; MG += oz;
        pg8::StaticOrder S; S.init(TP, 1024, (int)gridDim.x, (int)blockIdx.x);
        EpiMerge<1> E; E.MG = MG; E.Z = wsb(p, OFF_Z);
        pg8::gemm_phase<EpiMerge<1>, pg8::StaticOrder, false>((LAS unsigned char*)sm, g, S, E, nullptr); }
    const int tid = threadIdx.x + opaque_zero(), w = tid >> 6, lane = tid & 63, fr = lane & 15, fq = lane >> 4;
    for (int t = w * (int)gridDim.x + (int)blockIdx.x; t < 512; t += 8 * (int)gridDim.x) { const int it = t >> 3, rt = t & 7;
        const f32x4 a = small_mma(wsb(p, OFF_OG) + (size_t)TP * 1024, 1024, wsb(p, OFF_WPA + l * SZ_WPA), 1024, 16 * rt, it * 16, fr, fq);
        const f32x4 b = small_mma(wsb(p, OFF_YC) + (size_t)TP * 512, 512, wsb(p, OFF_WPB + l * SZ_WPB), 512, 16 * rt, it * 16, fr, fq);
#pragma unroll
        for (int j = 0; j < 4; ++j) { const int r = TP + 16 * rt + 4 * fq + j, c = it * 16 + fr; const bf16_t* z = wsb(p, OFF_Z) + (size_t)r * NZ;
            MG[(size_t)r * 1024 + c] = f2bf(sigmoidf_(bf2f(z[ZMG + c])) * a[j] + sigmoidf_(bf2f(z[ZMC + c])) * b[j]); }
    }
}
__device__ __forceinline__ void phase5(const P& p, unsigned char* sm, int l) {
    bf16_t* GO = wsb(p, OFF_Z); const float* ada = wsf(p, OFF_ADA) + (size_t)l * NADA * 3072;
    {   pg8::Gemm g; g.A = wsb(p, OFF_U); g.Bt = wsb(p, OFF_WO + l * SZ_WO); g.M = TP; g.N = 1024; g.K = 1024;
        pg8::StaticOrder S; S.init(TP, 1024, (int)gridDim.x, (int)blockIdx.x);
        EpiGate E; E.GO = GO; E.ada = ada;
        pg8::gemm_phase<EpiGate, pg8::StaticOrder, false>((LAS unsigned char*)sm, g, S, E, nullptr); }
    const int tid = threadIdx.x + opaque_zero(), w = tid >> 6, lane = tid & 63, fr = lane & 15, fq = lane >> 4;
#ifndef NO_SMALL
    for (int t = w * (int)gridDim.x + (int)blockIdx.x; t < 512; t += 8 * (int)gridDim.x) { const int it = t >> 3, rt = t & 7;
        const f32x4 a = small_mma(wsb(p, OFF_U) + (size_t)TP * 1024, 1024, wsb(p, OFF_WO + l * SZ_WO), 1024, 16 * rt, it * 16, fr, fq);
#pragma unroll
        for (int j = 0; j < 4; ++j) { const int r = TP + 16 * rt + 4 * fq + j, c = it * 16 + fr;
            GO[(size_t)r * 1024 + c] = f2bf(ada[(size_t)ada_row(r) * 3072 + 2048 + c] * a[j]); }
    }
#endif
}

DI bf16x8 cat8(u32x2 lo, u32x2 hi) { u32x4 v; v.x = lo.x; v.y = lo.y; v.z = hi.x; v.w = hi.y; return __builtin_bit_cast(bf16x8, v); }
__device__ __forceinline__ void gla_state(const P& p, int l, int bh, int s) {
    const int tid = threadIdx.x + opaque_zero(), w = tid >> 6, lane = tid & 63, fr = lane & 15, fq = lane >> 4;
    const int b = bh >> 2, h = bh & 3;
    const bf16_t* KT = wsb(p, OFF_KST) + (size_t)bh * 32 * 8192 + ((w * 2) * 64 + lane) * 8;
    const bf16_t* VT = wsb(p, OFF_VT) + (size_t)bh * 32 * 16384 + ((2 * s * 2) * 64 + lane) * 8;
    const float* DB = wsf(p, OFF_B) + ((size_t)b * SEQ + 63) * 512 + h * 128 + 16 * w + 4 * fq;
    bf16_t* SP = (bf16_t*)(p.out + OUT_Y) + (size_t)bh * 32 * 32768 + (((2 * s) * 4 + (w >> 1)) * 64 + (2 * (w & 1) + (fq >> 1)) * 16 + fr) * 8 + 4 * (fq & 1);
    f32x4 S0 = {0.f, 0.f, 0.f, 0.f}, S1 = {0.f, 0.f, 0.f, 0.f};
    bf16x8 ra[4][2], rv[4][4]; f32x4 rd[4];
#define GS_LD(u, c) do { const bf16_t* k_ = KT + (size_t)(c) * 8192; const bf16_t* v_ = VT + (size_t)(c) * 16384; \
        ra[u][0] = *(const bf16x8*)k_; ra[u][1] = *(const bf16x8*)(k_ + 512); \
        rv[u][0] = *(const bf16x8*)v_; rv[u][1] = *(const bf16x8*)(v_ + 512); rv[u][2] = *(const bf16x8*)(v_ + 1024); rv[u][3] = *(const bf16x8*)(v_ + 1024 + 512); \
        rd[u] = *(const f32x4*)(DB + (size_t)(c) * 64 * 512); } while (0)
    GS_LD(0, 0); GS_LD(1, 1); GS_LD(2, 2); GS_LD(3, 3);
    for (int c = 0; c < SEQ / 64; c += 4) {
#pragma unroll
        for (int u = 0; u < 4; ++u) {
            u32x2 t0, t1; t0.x = cvt_pk_bf16(S0[0], S0[1]); t0.y = cvt_pk_bf16(S0[2], S0[3]); t1.x = cvt_pk_bf16(S1[0], S1[1]); t1.y = cvt_pk_bf16(S1[2], S1[3]);
            bf16_t* sp = SP + (size_t)(c + u) * 32768;
            *(u32x2*)sp = t0; *(u32x2*)(sp + 2048) = t1;
            f32x4 d; d[0] = __expf(rd[u][0]); d[1] = __expf(rd[u][1]); d[2] = __expf(rd[u][2]); d[3] = __expf(rd[u][3]);
            S0 *= d; S1 *= d;
            S0 = mfma16(ra[u][0], rv[u][0], S0); S0 = mfma16(ra[u][1], rv[u][1], S0);
            S1 = mfma16(ra[u][0], rv[u][2], S1); S1 = mfma16(ra[u][1], rv[u][3], S1);
            if (c + u + 4 < SEQ / 64) GS_LD(u, c + u + 4);
        }
    }
#undef GS_LD
    float* So = p.out + OUT_GP + ((size_t)l * 32 + bh) * 128 * 256 + (size_t)(16 * w + 4 * fq) * 256 + 32 * s + fr;
#pragma unroll
    for (int e = 0; e < 4; ++e) { So[e * 256] = S0[e]; So[e * 256 + 16] = S1[e]; }
}
__device__ __forceinline__ void gla_out(const P& p, unsigned char* sm, int l, int unit) {
    const int tid = threadIdx.x + opaque_zero(), w = tid >> 6, lane = tid & 63, fr = lane & 15, fq = lane >> 4;
    LAS unsigned char* L = (LAS unsigned char*)sm;
    constexpr int oAT = 0, oRS = 9216, oRSTD = 11264, oOT = 12288;
    const int bh = unit >> 5, c = unit & 31, b = bh >> 2, h = bh & 3;
    const size_t r0 = (size_t)b * SEQ + (size_t)c * 64;
    const bf16_t* Z = wsb(p, OFF_Z);
    const bf16_t* Zq = wsb(p, OFF_QF) + (size_t)unit * 8192 + lane * 8;
    const bf16_t* Zk = wsb(p, OFF_KF) + (size_t)unit * 8192 + lane * 8;
    const bf16_t* VTu = wsb(p, OFF_VT) + (size_t)unit * 16384 + ((2 * w * 2) * 64 + lane) * 8;
    const bf16_t* SPu = (const bf16_t*)(p.out + OUT_Y) + (size_t)unit * 32768 + ((2 * w * 4) * 64 + lane) * 8;
    const bf16_t* gg = Z + (r0 + (tid >> 5)) * NZ + ZG + h * 256 + (tid & 31) * 8;
    bf16_t* go = wsb(p, OFF_OG) + (r0 + (tid >> 5)) * 1024 + h * 256 + (tid & 31) * 8;
    const int tb = (fr * 72 + 8 * fq) * 2;
    const float gn0 = p.gng[l * 256 + 32 * w + fr], gn1 = p.gng[l * 256 + 32 * w + 16 + fr];
    __syncthreads();
    {   const int it = w >> 1;
#pragma unroll
        for (int jj = 0; jj < 2; ++jj) { const int jt = (w & 1) * 2 + jj; f32x4 a = {0.f, 0.f, 0.f, 0.f};
            if (jt <= it) {
#pragma unroll
                for (int ks = 0; ks < 4; ++ks) a = mfma16(*(const bf16x8*)(Zq + (it * 4 + ks) * 512), *(const bf16x8*)(Zk + (jt * 4 + ks) * 512), a); }
#pragma unroll
            for (int e = 0; e < 4; ++e) { const int i = it * 16 + 4 * fq + e, j = jt * 16 + fr; *(LAS bf16_t*)(L + oAT + (i * 72 + j) * 2) = (j <= i) ? f2bf(a[e]) : (bf16_t)0; } } }
    u32x4 rg[4];
#pragma unroll
    for (int e = 0; e < 4; ++e) rg[e] = *(const u32x4*)(gg + (size_t)(16 * e) * NZ);
    bf16x8 vb[2][2];
#pragma unroll
    for (int nt = 0; nt < 2; ++nt)
#pragma unroll
        for (int js = 0; js < 2; ++js) vb[nt][js] = *(const bf16x8*)(VTu + nt * 1024 + js * 512);
    bf16x8 sbr[4][2], qfr[4][4];
#pragma unroll
    for (int ks = 0; ks < 4; ++ks) { sbr[ks][0] = *(const bf16x8*)(SPu + ks * 512); sbr[ks][1] = *(const bf16x8*)(SPu + 2048 + ks * 512);
#pragma unroll
        for (int it = 0; it < 4; ++it) qfr[ks][it] = *(const bf16x8*)(Zq + (it * 4 + ks) * 512); }
    __syncthreads();
    f32x4 o[4][2];
#pragma unroll
    for (int it = 0; it < 4; ++it) { o[it][0] = (f32x4){0.f, 0.f, 0.f, 0.f}; o[it][1] = (f32x4){0.f, 0.f, 0.f, 0.f}; }
#pragma unroll
    for (int ks = 0; ks < 4; ++ks) {
#pragma unroll
        for (int it = 0; it < 4; ++it) { o[it][0] = mfma16(qfr[ks][it], sbr[ks][0], o[it][0]); o[it][1] = mfma16(qfr[ks][it], sbr[ks][1], o[it][1]); } }
#pragma unroll
    for (int it = 0; it < 4; ++it)
#pragma unroll
        for (int js = 0; js < 2; ++js) { if (js == 1 && it < 2) continue;
            const bf16x8 a = *(const LAS bf16x8*)(L + oAT + tb + it * 16 * 144 + js * 64);
            o[it][0] = mfma16(a, vb[0][js], o[it][0]); o[it][1] = mfma16(a, vb[1][js], o[it][1]); }
#pragma unroll
    for (int it = 0; it < 4; ++it)
#pragma unroll
        for (int e = 0; e < 4; ++e) { float s = o[it][0][e] * o[it][0][e] + o[it][1][e] * o[it][1][e];
            s += __shfl_xor(s, 1); s += __shfl_xor(s, 2); s += __shfl_xor(s, 4); s += __shfl_xor(s, 8);
            if (fr == 0) *(LAS float*)(L + oRS + (w * 64 + it * 16 + 4 * fq + e) * 4) = s; }
    __syncthreads();
    if (tid < 64) { float s = 0.f;
#pragma unroll
        for (int ww = 0; ww < 8; ++ww) s += *(const LAS float*)(L + oRS + (ww * 64 + tid) * 4);
        *(LAS float*)(L + oRSTD + tid * 4) = rsqrtf(s * (1.0f / 256.0f) + EPS); }
    __syncthreads();
#pragma unroll
    for (int it = 0; it < 4; ++it) { const f32x4 rsd = *(const LAS f32x4*)(L + oRSTD + (it * 16 + 4 * fq) * 4);
#pragma unroll
        for (int e = 0; e < 4; ++e) { const int i = it * 16 + 4 * fq + e;
            *(LAS bf16_t*)(L + oOT + (i * 264 + 32 * w + fr) * 2) = f2bf(o[it][0][e] * rsd[e] * gn0); *(LAS bf16_t*)(L + oOT + (i * 264 + 32 * w + 16 + fr) * 2) = f2bf(o[it][1][e] * rsd[e] * gn1); } }
    __syncthreads();
#pragma unroll
    for (int e = 0; e < 4; ++e) { const u32x4 ov = *(const LAS u32x4*)(L + oOT + (((tid >> 5) + 16 * e) * 264 + (tid & 31) * 8) * 2); const u32x4 g = rg[e];
        u32x4 r; r.x = cvt_pk_bf16(bflo(ov.x) * siluf_(bflo(g.x)), bfhi(ov.x) * siluf_(bfhi(g.x))); r.y = cvt_pk_bf16(bflo(ov.y) * siluf_(bflo(g.y)), bfhi(ov.y) * siluf_(bfhi(g.y)));
        r.z = cvt_pk_bf16(bflo(ov.z) * siluf_(bflo(g.z)), bfhi(ov.z) * siluf_(bfhi(g.z))); r.w = cvt_pk_bf16(bflo(ov.w) * siluf_(bflo(g.w)), bfhi(ov.w) * siluf_(bfhi(g.w)));
        *(u32x4*)(go + (size_t)(16 * e) * 1024) = r; }
}
DI void unpack8(const u32x4 a, float (&f)[8]) { f[0] = bflo(a.x); f[1] = bfhi(a.x); f[2] = bflo(a.y); f[3] = bfhi(a.y); f[4] = bflo(a.z); f[5] = bfhi(a.z); f[6] = bflo(a.w); f[7] = bfhi(a.w); }
DI void conv_piece(const P& p, int l, int r, int cgp, const float (&w0)[8], const float (&w1)[8], const float (&w2)[8], bool prompt) {
    float z0[8], z1[8], z2[8], cg[8];
    if (prompt) { const bf16_t* zr = wsb(p, OFF_Z) + (size_t)r * NZ; const int t = r & (SEQ - 1);
        unpack8(*(const u32x4*)(zr + ZZ + cgp * 8), z0); unpack8(*(const u32x4*)(zr + ZCG + cgp * 8), cg);
#pragma unroll
        for (int e = 0; e < 8; ++e) { z1[e] = 0.f; z2[e] = 0.f; }
        if (t >= 1) unpack8(*(const u32x4*)(zr - NZ + ZZ + cgp * 8), z1);
        if (t >= 2) unpack8(*(const u32x4*)(zr - 2 * NZ + ZZ + cgp * 8), z2);
        if (t >= SEQ - 2) { float* dst = p.out + OUT_CP + (((size_t)l * NBATCH + (r >> 11)) * 2 + (t - (SEQ - 2))) * 512 + cgp * 8;
            *(float4*)dst = (float4){z0[0], z0[1], z0[2], z0[3]}; *(float4*)(dst + 4) = (float4){z0[4], z0[5], z0[6], z0[7]}; }
    } else { const int sr = r - TP; const bf16_t* zs = wsb(p, OFF_ZS) + (size_t)sr * ZSW + 2048 + cgp * 8;
        float a[8], b[8];
        unpack8(*(const u32x4*)zs, a); unpack8(*(const u32x4*)(zs + 512), b);
#pragma unroll
        for (int e = 0; e < 8; ++e) z0[e] = a[e] * b[e];
        unpack8(*(const u32x4*)(zs + 1024), a); unpack8(*(const u32x4*)(zs + 1536), b);
#pragma unroll
        for (int e = 0; e < 8; ++e) cg[e] = a[e] * siluf_(b[e]);
        const float* b0 = p.sconv + (((size_t)l * SB + sr) * 2 + 0) * 512 + cgp * 8; const float* b1 = b0 + 512;
        const float4 a0 = *(const float4*)b0, a1 = *(const float4*)(b0 + 4), c0 = *(const float4*)b1, c1 = *(const float4*)(b1 + 4);
        z2[0] = a0.x; z2[1] = a0.y; z2[2] = a0.z; z2[3] = a0.w; z2[4] = a1.x; z2[5] = a1.y; z2[6] = a1.z; z2[7] = a1.w;
        z1[0] = c0.x; z1[1] = c0.y; z1[2] = c0.z; z1[3] = c0.w; z1[4] = c1.x; z1[5] = c1.y; z1[6] = c1.z; z1[7] = c1.w;
        float* dst = p.out + OUT_CS + (((size_t)l * SB + sr) * 2) * 512 + cgp * 8;
        *(float4*)dst = c0; *(float4*)(dst + 4) = c1;
        *(float4*)(dst + 512) = (float4){z0[0], z0[1], z0[2], z0[3]}; *(float4*)(dst + 516) = (float4){z0[4], z0[5], z0[6], z0[7]}; }
    float y[8];
#pragma unroll
    for (int e = 0; e < 8; ++e) y[e] = cg[e] * (w0[e] * z2[e] + w1[e] * z1[e] + w2[e] * z0[e]);
    u32x4 o; o.x = cvt_pk_bf16(y[0], y[1]); o.y = cvt_pk_bf16(y[2], y[3]); o.z = cvt_pk_bf16(y[4], y[5]); o.w = cvt_pk_bf16(y[6], y[7]);
    *(u32x4*)(wsb(p, OFF_YC) + (size_t)r * 512 + cgp * 8) = o;
}
__device__ __forceinline__ void p3_other(const P& p, unsigned char* sm, int l, int first, int nblk) {
    const int tid = threadIdx.x + opaque_zero(), w = tid >> 6, lane = tid & 63;
    float* qf = (float*)sm; float* kif = qf + 128; float* ksf = kif + 128; float* af = ksf + 128; float* vf = af + 128; float* OP = vf + 256; float* red = OP + 2048;
    const bf16_t* Z = wsb(p, OFF_Z);
    for (int it = (int)blockIdx.x - first; it < 512 + 256; it += nblk) {
        if (it < 512) {
            const int sb = it >> 2, h = it & 3, r = TP + sb;
            __syncthreads();
            const bf16_t* ZS = wsb(p, OFF_ZS) + (size_t)sb * ZSW;
            if (tid < 128) { qf[tid] = bf2f(ZS[ZQ + h * 128 + tid]); kif[tid] = bf2f(ZS[ZK + h * 128 + tid]);
                ksf[tid] = bf2f(wsb(p, OFF_KST)[(size_t)r * 512 + h * 128 + tid]); af[tid] = __expf(wsf(p, OFF_B)[(size_t)r * 512 + h * 128 + tid]); }
            else if (tid < 384) vf[tid - 128] = bf2f(ZS[ZV + h * 256 + tid - 128]);
            __syncthreads();
            const float* S0 = p.sgla + ((((size_t)l * SB + sb) * 4 + h) * 128) * 256; float* S1 = p.out + OUT_GS + ((((size_t)l * SB + sb) * 4 + h) * 128) * 256;
            const float4 v4 = *(const float4*)(vf + 4 * lane); float4 op = {0.f, 0.f, 0.f, 0.f};
            f32x4 sv[16];
#pragma unroll
            for (int kk = 0; kk < 16; ++kk) sv[kk] = __builtin_nontemporal_load((const f32x4*)(S0 + (size_t)(w * 16 + kk) * 256 + 4 * lane));
#pragma unroll
            for (int kk = 0; kk < 16; ++kk) { const int k = w * 16 + kk; const f32x4 s = sv[kk]; const float a = af[k], ks = ksf[k], q = qf[k];
                f32x4 sn; sn[0] = fmaf(a, s[0], ks * v4.x); sn[1] = fmaf(a, s[1], ks * v4.y); sn[2] = fmaf(a, s[2], ks * v4.z); sn[3] = fmaf(a, s[3], ks * v4.w);
                __builtin_nontemporal_store(sn, (f32x4*)(S1 + (size_t)k * 256 + 4 * lane));
                op.x = fmaf(q, s[0], op.x); op.y = fmaf(q, s[1], op.y); op.z = fmaf(q, s[2], op.z); op.w = fmaf(q, s[3], op.w); }
            *(float4*)(OP + w * 256 + 4 * lane) = op;
            __syncthreads();
            float ov = 0.f;
            if (tid < 256) { float qk = 0.f;
                for (int k = 0; k < 128; ++k) qk = fmaf(qf[k], kif[k], qk);
                ov = qk * vf[tid];
#pragma unroll
                for (int ww = 0; ww < 8; ++ww) ov += OP[ww * 256 + tid];
                const float ss = wave_sum(ov * ov); if (lane == 0) red[w] = ss; }
            __syncthreads();
            if (tid < 256) { const float rstd = rsqrtf((red[0] + red[1] + red[2] + red[3]) * (1.0f / 256.0f) + EPS);
                const float g = bf2f(Z[(size_t)r * NZ + ZG + h * 256 + tid]);
                wsb(p, OFF_OG)[(size_t)r * 1024 + h * 256 + tid] = f2bf(ov * rstd * p.gng[l * 256 + tid] * siluf_(g)); }
        } else {
            const int ch = it - 512, cgp = tid & 63;
            float w0[8], w1[8], w2[8];
#pragma unroll
            for (int e = 0; e < 8; ++e) { w0[e] = p.conv_w[(l * 3 + 0) * 512 + cgp * 8 + e]; w1[e] = p.conv_w[(l * 3 + 1) * 512 + cgp * 8 + e]; w2[e] = p.conv_w[(l * 3 + 2) * 512 + cgp * 8 + e]; }
#pragma unroll
            for (int e8 = 0; e8 < 8; ++e8) conv_piece(p, l, ch * 64 + (tid >> 6) + 8 * e8, cgp, w0, w1, w2, true);
            if (tid < 32) { const int cg2 = (ch & 1) * 32 + tid;
#pragma unroll
                for (int e = 0; e < 8; ++e) { w0[e] = p.conv_w[(l * 3 + 0) * 512 + cg2 * 8 + e]; w1[e] = p.conv_w[(l * 3 + 1) * 512 + cg2 * 8 + e]; w2[e] = p.conv_w[(l * 3 + 2) * 512 + cg2 * 8 + e]; }
                conv_piece(p, l, TP + (ch >> 1), cg2, w0, w1, w2, false); }
        }
    }
}
__device__ __forceinline__ void phase3a(const P& p, unsigned char* sm, int l) {
    for (int i = blockIdx.x; i < 256; i += gridDim.x) { const int x = i & 7, j = i >> 3; gla_state(p, l, x * 4 + (j >> 3), j & 7); }
#ifdef PROBE_GS
    __syncthreads(); for (int i = blockIdx.x; i < 256; i += gridDim.x) gla_state(p, l, i >> 3, i & 7);
#endif
    p3_other(p, sm, l, 0, (int)gridDim.x);
#ifdef PROBE_OT
    __syncthreads(); p3_other(p, sm, l, 0, (int)gridDim.x);
#endif
}
__device__ __forceinline__ void phase3b(const P& p, unsigned char* sm, int l) {
    for (int u = blockIdx.x; u < 1024; u += gridDim.x) gla_out(p, sm, l, u);
}

__global__ void __launch_bounds__(NTHR, 2) fwd_mega(P p) {
    extern __shared__ __attribute__((aligned(16))) unsigned char smem[];
    cg::grid_group grid = cg::this_grid();
    volatile LAS unsigned* bst = (volatile LAS unsigned*)((LAS unsigned char*)smem + LDS_BYTES - 64);
    if (threadIdx.x < 16) bst[threadIdx.x] = 0u;
    __syncthreads();
    if (p.ph_hi > 1000) grid.sync();
#if USE_XCD_BAR
    XcdBarrier bar; bar.bar = (unsigned*)(p.ws + OFF_CTL); bar.x = 0; bar.st = nullptr;
    if (p.ph_hi - p.ph_lo > 1) bar = xcd_barrier_post((unsigned*)(p.ws + OFF_CTL), bst);
#endif
#ifndef PH_MASK
#define PH_MASK 0xffff
#endif
#define PHON(k) ((PH_MASK >> (k)) & 1)
#if USE_XCD_BAR
#define SEAM(k) do { if ((k) + 1 < p.ph_hi) xcd_barrier(bar); } while (0)
#else
#define SEAM(k) do { if ((k) + 1 < p.ph_hi) grid.sync(); } while (0)
#endif
#ifndef REPEAT_PH
#define REPEAT_PH -1
#endif
#ifndef REPEAT_BAR
#define REPEAT_BAR 0
#endif
#define RUN(k, call) do { if (p.ph_lo <= (k) && (k) < p.ph_hi) { if (PHON(k)) { call; } if (REPEAT_PH == (k)) { __syncthreads(); call; } SEAM(k); if (REPEAT_BAR && (k) > 0) { SEAM(k); SEAM(k); } } } while (0)
    RUN(0, phase0(p, smem));
    RUN(1, phase1(p, smem, 0, 0); p0_convert(p, smem));
    RUN(2, phase2(p, smem, 0));
    RUN(3, phase3a(p, smem, 0));
    RUN(4, phase3b(p, smem, 0));
    RUN(5, phase4(p, smem, 0));
    RUN(6, phase5(p, smem, 0));
    RUN(7, phase1(p, smem, 1, 1));
    RUN(8, phase2(p, smem, 1));
    RUN(9, phase3a(p, smem, 1));
    RUN(10, phase3b(p, smem, 1));
    RUN(11, phase4(p, smem, 1));
    RUN(12, phase5(p, smem, 1));
    RUN(13, phase1(p, smem, 1, 2));
}

extern "C" void kernel_launch(void* const* d_in, const int* in_sizes, int n_in, void* d_out, int out_size, void* d_ws, size_t ws_size, hipStream_t stream) {
    static int grid = 0;
    if (grid == 0) {
        if (n_in != 18 || (size_t)out_size != OUT_END || ws_size < WS_END) { fprintf(stderr, "kernel_launch: unexpected sizes: n_in %d out %d (want %zu) ws %zu (want >= %zu)\n", n_in, out_size, (size_t)OUT_END, ws_size, (size_t)WS_END); grid = -1; return; }
        int dev = 0, cus = 0, per_cu = 0;
        hipGetDevice(&dev); hipDeviceGetAttribute(&cus, hipDeviceAttributeMultiprocessorCount, dev);
        if (hipFuncSetAttribute((const void*)fwd_mega, hipFuncAttributeMaxDynamicSharedMemorySize, LDS_BYTES) != hipSuccess) { fprintf(stderr, "kernel_launch: hipFuncSetAttribute failed\n"); grid = -1; return; }
        if (hipOccupancyMaxActiveBlocksPerMultiprocessor(&per_cu, (const void*)fwd_mega, NTHR, LDS_BYTES) != hipSuccess || per_cu < 1) { fprintf(stderr, "kernel_launch: occupancy query failed (%d)\n", per_cu); per_cu = 1; (void)hipGetLastError(); }
        grid = cus;
    }
    if (grid < 0) return;
    hipMemsetAsync((char*)d_ws + OFF_CTL, 0, SZ_CTL, stream);
    P p{};
    p.xp = (const float*)d_in[0]; p.xs = (const float*)d_in[1]; p.cp = (const float*)d_in[2]; p.cs = (const float*)d_in[3]; p.sgla = (const float*)d_in[4]; p.sconv = (const float*)d_in[5];
    p.w_ada = (const float*)d_in[6]; p.b_ada = (const float*)d_in[7]; p.w_in = (const float*)d_in[8]; p.w_a2 = (const float*)d_in[9]; p.b_a = (const float*)d_in[10]; p.gng = (const float*)d_in[11];
    p.conv_w = (const float*)d_in[12]; p.w_pa = (const float*)d_in[13]; p.w_pb = (const float*)d_in[14]; p.w_o = (const float*)d_in[15]; p.ln_g = (const float*)d_in[16]; p.ln_b = (const float*)d_in[17];
    p.out = (float*)d_out; p.ws = (unsigned char*)d_ws;
#if N_LAUNCH_PER_PHASE
    for (int ph = 0; ph < 14; ++ph) { p.ph_lo = ph; p.ph_hi = ph + 1; hipLaunchKernelGGL(fwd_mega, dim3(grid), dim3(NTHR), LDS_BYTES, stream, p); }
#else
    p.ph_lo = 0; p.ph_hi = 14;
    void* args[] = {&p};
    hipError_t e = hipLaunchCooperativeKernel((const void*)fwd_mega, dim3(grid), dim3(NTHR), args, LDS_BYTES, stream);
    if (e != hipSuccess) fprintf(stderr, "kernel_launch: cooperative launch failed: %s (grid %d)\n", hipGetErrorString(e), grid);
#endif
}
```
